# Optimizing an MI355X kernel written in HIP

```python
import math
import jax, jax.numpy as jnp
from jax import lax
import numpy as np

D_MODEL = 1024
BATCH = 4
SEQ = 4096
DEPTH = 4
DEC_BATCH = 32
DEC_SEQ = 1
PAST_LEN = 8192
PAGE_SIZE = 128

N_MIXERS = 2
N_CONV_LAYERS = (DEPTH + 1) // 2
N_ATTN_LAYERS = DEPTH // 2
SC_WIDTH = 3
GROUPS = ((128, 1), (512, 4), (2048, 16))
N_GROUPS = len(GROUPS)
H_SLOT = 8
HEAD_DIM = 64
ATTN_WIDTH = H_SLOT * HEAD_DIM
QKV_WIDTH = N_GROUPS * 3 * ATTN_WIDTH
N_BUCKETS = 32
MAX_DISTANCE = 2048
QB = 128
D_FF = 2816
FFN_CONV_WIDTH = 3
EPS = 1e-6
SCALE = HEAD_DIM ** -0.5
NEG = -1e30

kernel_name = 'hybrid_shortconv_dilated_swa_convffn_step'


def rmsnorm(x, g):
    xf = x.astype(jnp.float32)
    r = lax.rsqrt(jnp.mean(xf * xf, axis=-1, keepdims=True) + EPS)
    return (xf * r).astype(x.dtype) * g


def causal_dwconv(u, hist, w):
    width = w.shape[0]
    t = u.shape[1]
    uh = jnp.concatenate([hist.astype(u.dtype), u], axis=1)
    out = w[0] * uh[:, 0:t]
    for j in range(1, width):
        out = out + w[j] * uh[:, j:j + t]
    return out, uh[:, uh.shape[1] - (width - 1):]


def shortconv_mixer(h, hist, w_in, conv_w, w_out):
    bg, cg, xv = jnp.split(h @ w_in, 3, axis=-1)
    conv, new_hist = causal_dwconv(cg * xv, hist, conv_w)
    return (bg * conv) @ w_out, new_hist


def convffn(h, hist, w_gate, w_up, conv_w, conv_b, w_down):
    gconv, new_hist = causal_dwconv(h @ w_gate, hist, conv_w)
    return (jax.nn.silu(gconv + conv_b) * (h @ w_up)) @ w_down, new_hist


def project_qkv(h, w_qkv, q_norm, k_norm):
    b, t, _ = h.shape
    p = (h @ w_qkv).reshape(b, t, N_GROUPS, 3, H_SLOT, HEAD_DIM)
    q = rmsnorm(p[:, :, :, 0], q_norm)
    k = rmsnorm(p[:, :, :, 1], k_norm)
    v = p[:, :, :, 2]
    return q, k, v


def _t5_bucket(dist):
    exact = N_BUCKETS // 2
    n = np.asarray(dist, dtype=np.float32)
    large = exact + np.log(np.maximum(n, 1.0) / exact) / math.log(MAX_DISTANCE / exact) * (N_BUCKETS - exact)
    large = np.minimum(np.floor(large), N_BUCKETS - 1)
    return np.where(n < exact, n, large).astype(np.int32)


def _group_biases(rel_bias):
    out = []
    for g, (win, dil) in enumerate(GROUPS):
        bucket = _t5_bucket(dil * np.arange(win // dil + 1))
        out.append(jnp.take(rel_bias, bucket, axis=0)[:, g * H_SLOT:(g + 1) * H_SLOT].T)
    return out


def dilated_branch(q, span_k, span_v, idx, valid, bias):
    idx_c = np.maximum(idx, 0).astype(np.int32)
    kg = jnp.take(span_k, idx_c, axis=1)
    vg = jnp.take(span_v, idx_c, axis=1)
    logits = jnp.einsum('bqhd,bqkhd->bqhk', q, kg, preferred_element_type=jnp.float32) * SCALE
    logits = logits + bias.astype(jnp.float32)[None, None]
    logits = jnp.where(valid[None, :, None, :], logits, NEG)
    m = jnp.max(logits, axis=-1, keepdims=True)
    e = jnp.exp(logits - m)
    s = jnp.sum(e, axis=-1, keepdims=True)
    out = jnp.einsum('bqhk,bqkhd->bqhd', (e / s).astype(span_v.dtype), vg)
    lse = (m + jnp.log(s))[..., 0]
    return out, lse


def merge_groups(outs, lses):
    w = jax.nn.softmax(jnp.stack(lses, axis=0), axis=0)
    out = w[0][..., None].astype(outs[0].dtype) * outs[0]
    for g in range(1, len(outs)):
        out = out + w[g][..., None].astype(outs[g].dtype) * outs[g]
    return out


def dilated_attention_prompt(q, k, v, biases):
    b, t = q.shape[0], q.shape[1]
    pads = []
    for g, (win, dil) in enumerate(GROUPS):
        pw = ((0, 0), (win, 0), (0, 0), (0, 0))
        pads.append((jnp.pad(k[:, :, g], pw), jnp.pad(v[:, :, g], pw)))
    qi = np.arange(QB, dtype=np.int32)[:, None]

    def block(t0):
        qb = lax.dynamic_slice_in_dim(q, t0, QB, axis=1)
        outs, lses = [], []
        for g, (win, dil) in enumerate(GROUPS):
            back = dil * np.arange(win // dil + 1, dtype=np.int32)[None, :]
            span_k = lax.dynamic_slice_in_dim(pads[g][0], t0, win + QB, axis=1)
            span_v = lax.dynamic_slice_in_dim(pads[g][1], t0, win + QB, axis=1)
            valid = (t0 + jnp.asarray(qi - back, dtype=jnp.int32)) >= 0
            o, l = dilated_branch(qb[:, :, g], span_k, span_v, qi + win - back, valid, biases[g])
            outs.append(o)
            lses.append(l)
        return merge_groups(outs, lses)

    out = lax.map(block, jnp.arange(t // QB, dtype=jnp.int32) * QB)
    out = jnp.moveaxis(out, 0, 1).reshape(b, t, ATTN_WIDTH)
    new_cache = []
    for g, (win, dil) in enumerate(GROUPS):
        keep = min(win, t)
        new_cache.append(jnp.stack([k[:, t - keep:, g], v[:, t - keep:, g]], axis=2))
    return out, new_cache


def dilated_attention_sample(q, k, v, caches, biases):
    b, s = q.shape[0], q.shape[1]
    qi = np.arange(s, dtype=np.int32)[:, None]
    outs, lses, new_cache = [], [], []
    for g, (win, dil) in enumerate(GROUPS):
        cache = caches[g]
        keep = cache.shape[1]
        back = dil * np.arange(win // dil + 1, dtype=np.int32)[None, :]
        span_k = jnp.concatenate([cache[:, :, 0], k[:, :, g]], axis=1)
        span_v = jnp.concatenate([cache[:, :, 1], v[:, :, g]], axis=1)
        idx = keep + qi - back
        o, l = dilated_branch(q[:, :, g], span_k, span_v, idx, jnp.asarray(idx >= 0), biases[g])
        outs.append(o)
        lses.append(l)
        n = span_k.shape[1]
        new_cache.append(jnp.stack([span_k[:, n - keep:], span_v[:, n - keep:]], axis=2))
    return merge_groups(outs, lses).reshape(b, s, ATTN_WIDTH), new_cache


def setup_inputs(seed: int = 0) -> dict:
    key = jax.random.key(seed)
    ks = jax.random.split(key, 24)

    def nrm(k, shape, scale):
        return scale * jax.random.normal(k, shape, jnp.float32)

    buf = [min(win, PAST_LEN) for win, _ in GROUPS]
    return {
        'x_prompt': nrm(ks[0], (BATCH, SEQ, D_MODEL), 1.0),
        'x_sample': nrm(ks[1], (DEC_BATCH, DEC_SEQ, D_MODEL), 1.0),
        'state_sc_conv': nrm(ks[2], (N_CONV_LAYERS, DEC_BATCH, SC_WIDTH - 1, D_MODEL), 1.0),
        'cache_kv_d1': nrm(ks[3], (N_ATTN_LAYERS, DEC_BATCH, buf[0], 2, H_SLOT, HEAD_DIM), 1.0),
        'cache_kv_d4': nrm(ks[4], (N_ATTN_LAYERS, DEC_BATCH, buf[1], 2, H_SLOT, HEAD_DIM), 1.0),
        'cache_kv_d16': nrm(ks[5], (N_ATTN_LAYERS, DEC_BATCH, buf[2], 2, H_SLOT, HEAD_DIM), 1.0),
        'state_ffn_conv': nrm(ks[6], (DEPTH, DEC_BATCH, FFN_CONV_WIDTH - 1, D_FF), 1.0),
        'norm_mix': 1.0 + nrm(ks[7], (DEPTH, D_MODEL), 0.02),
        'norm_ffn': 1.0 + nrm(ks[8], (DEPTH, D_MODEL), 0.02),
        'sc_w_in': nrm(ks[9], (N_CONV_LAYERS, D_MODEL, 3 * D_MODEL), D_MODEL ** -0.5),
        'sc_conv_w': nrm(ks[10], (N_CONV_LAYERS, SC_WIDTH, D_MODEL), SC_WIDTH ** -0.5),
        'sc_w_out': nrm(ks[11], (N_CONV_LAYERS, D_MODEL, D_MODEL), D_MODEL ** -0.5),
        'attn_w_qkv': nrm(ks[12], (N_ATTN_LAYERS, D_MODEL, QKV_WIDTH), D_MODEL ** -0.5),
        'attn_q_norm': 1.0 + nrm(ks[13], (N_ATTN_LAYERS, HEAD_DIM), 0.02),
        'attn_k_norm': 1.0 + nrm(ks[14], (N_ATTN_LAYERS, HEAD_DIM), 0.02),
        'attn_w_out': nrm(ks[15], (N_ATTN_LAYERS, ATTN_WIDTH, D_MODEL), ATTN_WIDTH ** -0.5),
        'rel_bias': nrm(ks[16], (N_BUCKETS, N_GROUPS * H_SLOT), 0.5),
        'ffn_w_gate': nrm(ks[17], (DEPTH, D_MODEL, D_FF), D_MODEL ** -0.5),
        'ffn_w_up': nrm(ks[18], (DEPTH, D_MODEL, D_FF), D_MODEL ** -0.5),
        'ffn_conv_w': nrm(ks[19], (DEPTH, FFN_CONV_WIDTH, D_FF), FFN_CONV_WIDTH ** -0.5),
        'ffn_conv_b': nrm(ks[20], (DEPTH, D_FF), 0.02),
        'ffn_w_down': nrm(ks[21], (DEPTH, D_FF, D_MODEL), D_FF ** -0.5),
    }


def reference(x_prompt, x_sample, state_sc_conv, cache_kv_d1, cache_kv_d4, cache_kv_d16, state_ffn_conv,
              norm_mix, norm_ffn, sc_w_in, sc_conv_w, sc_w_out, attn_w_qkv, attn_q_norm, attn_k_norm,
              attn_w_out, rel_bias, ffn_w_gate, ffn_w_up, ffn_conv_w, ffn_conv_b, ffn_w_down):
    biases = _group_biases(rel_bias)
    xp, xs = x_prompt, x_sample
    bp = xp.shape[0]
    sample_caches = (cache_kv_d1, cache_kv_d4, cache_kv_d16)
    p_sc, s_sc, p_ffn, s_ffn = [], [], [], []
    p_kv = [[] for _ in range(N_GROUPS)]
    s_kv = [[] for _ in range(N_GROUPS)]
    for i in range(DEPTH):
        j = i // N_MIXERS
        hp = rmsnorm(xp, norm_mix[i])
        hs = rmsnorm(xs, norm_mix[i])
        if i % N_MIXERS == 0:
            zero = jnp.zeros((bp, SC_WIDTH - 1, D_MODEL), xp.dtype)
            mp, hist_p = shortconv_mixer(hp, zero, sc_w_in[j], sc_conv_w[j], sc_w_out[j])
            ms, hist_s = shortconv_mixer(hs, state_sc_conv[j], sc_w_in[j], sc_conv_w[j], sc_w_out[j])
            p_sc.append(hist_p)
            s_sc.append(hist_s)
        else:
            qp, kp, vp = project_qkv(hp, attn_w_qkv[j], attn_q_norm[j], attn_k_norm[j])
            op, cp = dilated_attention_prompt(qp, kp, vp, biases)
            qs, ks_, vs = project_qkv(hs, attn_w_qkv[j], attn_q_norm[j], attn_k_norm[j])
            os_, cs = dilated_attention_sample(qs, ks_, vs, [c[j] for c in sample_caches], biases)
            mp = op @ attn_w_out[j]
            ms = os_ @ attn_w_out[j]
            for g in range(N_GROUPS):
                p_kv[g].append(cp[g])
                s_kv[g].append(cs[g])
        xp = xp + mp
        xs = xs + ms
        hp = rmsnorm(xp, norm_ffn[i])
        hs = rmsnorm(xs, norm_ffn[i])
        zero_f = jnp.zeros((bp, FFN_CONV_WIDTH - 1, D_FF), xp.dtype)
        fp, fh_p = convffn(hp, zero_f, ffn_w_gate[i], ffn_w_up[i], ffn_conv_w[i], ffn_conv_b[i], ffn_w_down[i])
        fs, fh_s = convffn(hs, state_ffn_conv[i], ffn_w_gate[i], ffn_w_up[i], ffn_conv_w[i], ffn_conv_b[i], ffn_w_down[i])
        p_ffn.append(fh_p)
        s_ffn.append(fh_s)
        xp = xp + fp
        xs = xs + fs
    return (xp, xs,
            jnp.stack(p_sc, axis=0), jnp.stack(p_kv[0], axis=0), jnp.stack(p_kv[1], axis=0),
            jnp.stack(p_kv[2], axis=0), jnp.stack(p_ffn, axis=0),
            jnp.stack(s_sc, axis=0), jnp.stack(s_kv[0], axis=0), jnp.stack(s_kv[1], axis=0),
            jnp.stack(s_kv[2], axis=0), jnp.stack(s_ffn, axis=0))
```

```cpp
#include <hip/hip_runtime.h>
#include <hip/hip_cooperative_groups.h>
#include <cstdio>
#include <cstdint>
#include <cmath>
namespace cg = cooperative_groups;
namespace pg8 {
#define PG8_LAS __attribute__((address_space(3)))
typedef unsigned short bf16_t;
typedef short bf16x8 __attribute__((ext_vector_type(8)));
typedef float f32x4 __attribute__((ext_vector_type(4)));
typedef unsigned u32x4 __attribute__((ext_vector_type(4)));
constexpr int BM = 256, BK = 64, HALF = 128, HTB = HALF * BK * 2  , STAGE_BYTES = 8 * HTB, NXCD = 8, WGM = 8;

__host__ __device__ __forceinline__ int lds_byte(int r, int c) { const int st = (r >> 4) * 2 + (c >> 5), rr = r & 15, cc = c & 31, ob = rr * 64 + cc * 2; return st * 1024 + (ob ^ (((ob >> 9) & 1) << 5)); }
__host__ __device__ __forceinline__ void stage_rc(int b, int& R, int& C) { const int st = b / 1024, sb = b % 1024, swz = sb ^ (((sb >> 9) & 1) << 5); R = (st >> 1) * 16 + swz / 64; C = (st & 1) * 32 + (swz % 64) / 2; }
__host__ __device__ __forceinline__ int perm32(int rho) { const int n = rho >> 4, i = rho & 15; return 8 * (i >> 2) + 4 * n + (i & 3); }

struct Unit { int pm, pn; };
struct Gemm { const bf16_t* A; const bf16_t* Bt; int M, N, K; };

struct StaticOrder {
    int nM, nN, nwg, G, c;
    __host__ __device__ __forceinline__ void init(int M, int N, int G_, int c_) { nM = M / BM; nN = N / BM; nwg = nM * nN; G = G_; c = c_; }
    __host__ __device__ __forceinline__ bool next(int i, Unit& u) const {
        const long L = (long)i * G + c; if (L >= nwg) return false;
        int wgid = (int)L; { const int q = nwg / NXCD, r = nwg % NXCD, xcd = wgid % NXCD, off = wgid / NXCD; wgid = (xcd < r ? xcd * (q + 1) : r * (q + 1) + (xcd - r) * q) + off; }
        const int nig = WGM * nN, gid = wgid / nig, fm = gid * WGM, gsz = (nM - fm) < WGM ? (nM - fm) : WGM;
        u.pm = fm + ((wgid % nig) % gsz); u.pn = (wgid % nig) / gsz; return true;
    }
    __device__ __forceinline__ void a_ready(const Unit&) const {}
    __device__ __forceinline__ void done(const Unit&) const {}
};

__device__ __forceinline__ unsigned cvt_pk_bf16(float lo, float hi) { unsigned r; asm volatile("v_cvt_pk_bf16_f32 %0, %1, %2" : "=v"(r) : "v"(lo), "v"(hi)); return r; }

template <class Epi, class Sched, bool ALIGN_EPI = false, bool SP2 = false>
__device__ __forceinline__ void gemm_phase(PG8_LAS unsigned char* lds, const Gemm g, const Sched& S, const Epi& E, int tid_in) {
    int tid_ = tid_in; asm volatile("" : "+v"(tid_));
    const int tid = tid_, wid = __builtin_amdgcn_readfirstlane(tid >> 6), lane = tid & 63, wr = wid >> 2, wc = wid & 3, fr = lane & 15, fq = lane >> 4;
    const int K = g.K, nt = K / BK;
    unsigned voffA[2], voffB[2];
#pragma unroll
    for (int i = 0; i < 2; ++i) { int R, C; stage_rc(tid * 16 + i * 8192, R, C); const int Rb = Epi::PERM ? ((R & ~31) + perm32(R & 31)) : R;
        const int Ra = Epi::APERM ? (64 * (R >> 6) + 4 * (R & 15) + ((R >> 4) & 3)) : R;
        voffA[i] = (unsigned)(Ra * K + C) * 2u; voffB[i] = (unsigned)(Rb * K + C) * 2u; }
    const size_t kstep = (size_t)(BK * 2);
    const size_t hstep = (size_t)HALF * K * 2;
    const size_t tstep = 2 * hstep;
    const unsigned ldsw = (unsigned)wid * 1024u;
    const int aoff = lds_byte(wr * 64 + fr, fq * 8), boff = lds_byte(wc * 32 + fr, fq * 8);
#define PG8_SA(b, h) (((b) * 2 + (h)) * HTB)
#define PG8_SB(b, h) ((4 + (b) * 2 + (h)) * HTB)
#define PG8_STAGE(bufoff, gbase, voff) do { _Pragma("unroll") for (int _i = 0; _i < 2; ++_i) \
        __builtin_amdgcn_global_load_lds((const unsigned*)((const char*)(gbase) + (voff)[_i]), (PG8_LAS unsigned*)(lds + (bufoff) + ldsw + _i * 8192), 16, 0, 0); } while (0)
#define PG8_LDA(dst, b, h) do { _Pragma("unroll") for (int m = 0; m < 4; ++m) _Pragma("unroll") for (int k = 0; k < 2; ++k) dst[m][k] = *(const PG8_LAS bf16x8*)(lds + PG8_SA(b, h) + aoff + m * 2048 + k * 1024); } while (0)
#define PG8_LDB(dst, b, h) do { _Pragma("unroll") for (int n = 0; n < 2; ++n) _Pragma("unroll") for (int k = 0; k < 2; ++k) dst[n][k] = *(const PG8_LAS bf16x8*)(lds + PG8_SB(b, h) + boff + n * 2048 + k * 1024); } while (0)
#define PG8_MMA(ai, bj, At, Bt) do { __builtin_amdgcn_s_setprio(1); _Pragma("unroll") for (int m = 0; m < 4; ++m) _Pragma("unroll") for (int n = 0; n < 2; ++n) _Pragma("unroll") for (int k = 0; k < 2; ++k) \
        acc[ai][bj][m][n] = __builtin_amdgcn_mfma_f32_16x16x32_bf16(Bt[n][k], At[m][k], acc[ai][bj][m][n], 0, 0, 0); __builtin_amdgcn_s_setprio(0); } while (0)
#define PG8_WAIT_V(n) asm volatile("s_waitcnt vmcnt(" #n ")" ::: "memory")
#define PG8_WAIT_L(n) asm volatile("s_waitcnt lgkmcnt(" #n ")" ::: "memory")
#define PG8_BAR __builtin_amdgcn_s_barrier()
#define PG8_SCHED __builtin_amdgcn_sched_barrier(0)
    Unit cur, nxt; int ui = 0;
    if (!S.next(0, cur)) return;
    f32x4 acc[2][2][4][2];
#pragma unroll
    for (int a = 0; a < 2; ++a)
#pragma unroll
        for (int b = 0; b < 2; ++b)
#pragma unroll
            for (int m = 0; m < 4; ++m)
#pragma unroll
                for (int n = 0; n < 2; ++n) acc[a][b][m][n] = (f32x4){0.f, 0.f, 0.f, 0.f};
    bf16x8 At[4][2], B0[2][2], B1[2][2];
    const char* cA = (const char*)g.A + (size_t)cur.pm * tstep; const char* cB = (const char*)g.Bt + (size_t)cur.pn * tstep;
    S.a_ready(cur);
    if constexpr (SP2) {
        PG8_STAGE(PG8_SB(0, 0), cB, voffB); PG8_STAGE(PG8_SB(0, 1), cB + hstep, voffB); PG8_STAGE(PG8_SA(0, 0), cA, voffA); PG8_STAGE(PG8_SA(0, 1), cA + hstep, voffA);
        if (wr == 1) PG8_BAR;
        PG8_WAIT_V(2); PG8_BAR;
        PG8_STAGE(PG8_SB(1, 0), cB + kstep, voffB); PG8_STAGE(PG8_SA(1, 0), cA + kstep, voffA); PG8_STAGE(PG8_SB(1, 1), cB + hstep + kstep, voffB);
        PG8_WAIT_V(6); PG8_BAR;
    } else {
        PG8_STAGE(PG8_SB(0, 0), cB, voffB); PG8_STAGE(PG8_SA(0, 0), cA, voffA); PG8_STAGE(PG8_SB(0, 1), cB + hstep, voffB); PG8_STAGE(PG8_SA(0, 1), cA + hstep, voffA);
        if (wr == 1) PG8_BAR;
        PG8_WAIT_V(4); PG8_BAR;
        PG8_STAGE(PG8_SB(1, 0), cB + kstep, voffB); PG8_STAGE(PG8_SA(1, 0), cA + kstep, voffA); PG8_STAGE(PG8_SB(1, 1), cB + hstep + kstep, voffB);
        PG8_WAIT_V(6); PG8_BAR;
    }
    for (;;) {
        const bool has_next = S.next(ui + 1, nxt);
        const char* nA = has_next ? (const char*)g.A + (size_t)nxt.pm * tstep : cA; const char* nB = has_next ? (const char*)g.Bt + (size_t)nxt.pn * tstep : cB;
        for (int t = 0; t < nt; t += 2) {
            const bool last = (t == nt - 2);
            const char* a1 = cA + (size_t)(t + 1) * kstep;
            const char* a2 = last ? nA : cA + (size_t)(t + 2) * kstep; const char* b2 = last ? nB : cB + (size_t)(t + 2) * kstep;
            const char* a3 = a2 + kstep; const char* b3 = b2 + kstep;
            if (last && has_next) S.a_ready(nxt);
            if constexpr (SP2) {
            PG8_LDB(B0, 0, 0); PG8_LDB(B1, 0, 1); PG8_SCHED; PG8_LDA(At, 0, 0); PG8_STAGE(PG8_SA(1, 1), a1 + hstep, voffA);
            PG8_WAIT_V(8); PG8_WAIT_L(0); PG8_BAR; PG8_MMA(0, 0, At, B0); PG8_MMA(0, 1, At, B1); PG8_BAR; PG8_SCHED;
            PG8_LDA(At, 0, 1); PG8_STAGE(PG8_SB(0, 0), b2, voffB); PG8_STAGE(PG8_SB(0, 1), b2 + hstep, voffB); PG8_STAGE(PG8_SA(0, 0), a2, voffA);
            PG8_WAIT_V(8); PG8_WAIT_L(0); PG8_BAR; PG8_MMA(1, 0, At, B0); PG8_MMA(1, 1, At, B1); PG8_BAR; PG8_SCHED;
            PG8_LDB(B0, 1, 0); PG8_LDB(B1, 1, 1); PG8_SCHED; PG8_LDA(At, 1, 0); PG8_STAGE(PG8_SA(0, 1), a2 + hstep, voffA);
            PG8_WAIT_V(8); PG8_WAIT_L(0); PG8_BAR; PG8_MMA(0, 0, At, B0); PG8_MMA(0, 1, At, B1); PG8_BAR; PG8_SCHED;
            PG8_LDA(At, 1, 1); PG8_STAGE(PG8_SB(1, 0), b3, voffB); PG8_STAGE(PG8_SB(1, 1), b3 + hstep, voffB); PG8_STAGE(PG8_SA(1, 0), a3, voffA);
            PG8_WAIT_V(8); PG8_WAIT_L(0); PG8_BAR; PG8_MMA(1, 0, At, B0); PG8_MMA(1, 1, At, B1); PG8_BAR; PG8_SCHED;
            } else {
            PG8_LDB(B0, 0, 0); PG8_SCHED; PG8_LDA(At, 0, 0); PG8_STAGE(PG8_SA(1, 1), a1 + hstep, voffA);
            PG8_WAIT_L(8); PG8_BAR; PG8_WAIT_L(0); PG8_MMA(0, 0, At, B0); PG8_BAR; PG8_SCHED;
            PG8_LDB(B1, 0, 1); PG8_STAGE(PG8_SB(0, 0), b2, voffB);
            PG8_BAR; PG8_WAIT_L(0); PG8_MMA(0, 1, At, B1); PG8_BAR;
            PG8_LDA(At, 0, 1); PG8_STAGE(PG8_SA(0, 0), a2, voffA);
            PG8_BAR; PG8_WAIT_L(0); PG8_MMA(1, 0, At, B0); PG8_BAR; PG8_SCHED;
            PG8_STAGE(PG8_SB(0, 1), b2 + hstep, voffB);
            PG8_WAIT_V(6); PG8_BAR; PG8_MMA(1, 1, At, B1); PG8_BAR;
            PG8_LDB(B0, 1, 0); PG8_SCHED; PG8_LDA(At, 1, 0); PG8_STAGE(PG8_SA(0, 1), a2 + hstep, voffA);
            PG8_WAIT_L(8); PG8_BAR; PG8_WAIT_L(0); PG8_MMA(0, 0, At, B0); PG8_BAR; PG8_SCHED;
            PG8_LDB(B1, 1, 1); PG8_STAGE(PG8_SB(1, 0), b3, voffB);
            PG8_BAR; PG8_WAIT_L(0); PG8_MMA(0, 1, At, B1); PG8_BAR;
            PG8_LDA(At, 1, 1); PG8_STAGE(PG8_SA(1, 0), a3, voffA);
            PG8_BAR; PG8_WAIT_L(0); PG8_MMA(1, 0, At, B0); PG8_BAR; PG8_SCHED;
            PG8_STAGE(PG8_SB(1, 1), b3 + hstep, voffB);
            PG8_WAIT_V(6); PG8_BAR; PG8_MMA(1, 1, At, B1); PG8_BAR;
            }
        }
        if constexpr (ALIGN_EPI) { if (wr == 0) PG8_BAR; }
        if constexpr (!Epi::AFTER_DRAIN) { E(acc, cur, wr, wc, fr, fq, ui); S.done(cur); }
        if (!has_next) break;
#pragma unroll
        for (int a = 0; a < 2; ++a)
#pragma unroll
            for (int b = 0; b < 2; ++b)
#pragma unroll
                for (int m = 0; m < 4; ++m)
#pragma unroll
                    for (int n = 0; n < 2; ++n) acc[a][b][m][n] = (f32x4){0.f, 0.f, 0.f, 0.f};
        cur = nxt; cA = nA; cB = nB; ++ui;
        if constexpr (ALIGN_EPI) { if (wr == 1) PG8_BAR; }
    }
    PG8_WAIT_V(0);
    if constexpr (!ALIGN_EPI) { if (wr == 0) PG8_BAR; }
    PG8_BAR;
    if constexpr (Epi::AFTER_DRAIN) { E.fused(acc, cur, wr, wc, fr, fq, lds, wid, lane); S.done(cur); }
#undef PG8_SA
#undef PG8_SB
#undef PG8_STAGE
#undef PG8_LDA
#undef PG8_LDB
#undef PG8_MMA
#undef PG8_WAIT_V
#undef PG8_WAIT_L
#undef PG8_BAR
#undef PG8_SCHED
}
}

constexpr int DM = 1024, NBATCH = 4, SEQ = 4096, M = NBATCH * SEQ, DEPTH = 4, SB = 32, DFF = 2816, NH = 8, HD = 64, AW = 512, QKVW = 4608;
constexpr int NWAVES = 8, NTHR = 512;
constexpr float EPS = 1e-6f, NEGF = -1e30f;

constexpr size_t O_YP = 0;
constexpr size_t O_YS = O_YP + (size_t)M * DM;
constexpr size_t O_PSC = O_YS + (size_t)SB * DM;
constexpr size_t O_PK1 = O_PSC + 2ull * NBATCH * 2 * DM;
constexpr size_t O_PK4 = O_PK1 + 2ull * NBATCH * 128 * 1024;
constexpr size_t O_PK16 = O_PK4 + 2ull * NBATCH * 512 * 1024;
constexpr size_t O_PFFN = O_PK16 + 2ull * NBATCH * 2048 * 1024;
constexpr size_t O_SSC = O_PFFN + 4ull * NBATCH * 2 * DFF;
constexpr size_t O_SK1 = O_SSC + 2ull * SB * 2 * DM;
constexpr size_t O_SK4 = O_SK1 + 2ull * SB * 128 * 1024;
constexpr size_t O_SK16 = O_SK4 + 2ull * SB * 512 * 1024;
constexpr size_t O_SFFN = O_SK16 + 2ull * SB * 2048 * 1024;
constexpr size_t O_END = O_SFFN + 4ull * SB * 2 * DFF;
static_assert(O_END == 215949312ull, "output size");

constexpr size_t MiB = 1u << 20;
constexpr size_t WS_CTL = 0;
constexpr size_t WS_INTAB = 28672;
constexpr size_t WS_WIN = 1 * MiB;
constexpr size_t WS_WOUT = WS_WIN + 2ull * 3072 * 1024 * 2;
constexpr size_t WS_WQKV = WS_WOUT + 2ull * 1024 * 1024 * 2;
constexpr size_t WS_WAO = WS_WQKV + 2ull * 4608 * 1024 * 2;
constexpr size_t WS_WGU = WS_WAO + 2ull * 1024 * 512 * 2;
constexpr size_t WS_WDN = WS_WGU + 4ull * 5632 * 1024 * 2;
constexpr size_t WS_HN = WS_WDN + 4ull * 1024 * 2816 * 2;
constexpr size_t WS_ZB = WS_HN + (size_t)M * DM * 2;
constexpr size_t WS_BGB = WS_ZB + (size_t)M * DM * 2;
constexpr size_t WS_UB = WS_BGB + (size_t)M * DM * 2;
constexpr size_t WS_GB = WS_UB + (size_t)M * DM * 2;
constexpr size_t WS_UPB = WS_GB + (size_t)M * DFF * 2;
constexpr size_t WS_ACT = WS_UPB + (size_t)M * DFF * 2;
constexpr size_t WS_QP = WS_ACT + (size_t)M * DFF * 2;
constexpr size_t WS_KP = WS_QP + 3ull * M * AW * 2;
constexpr size_t WS_VP = WS_KP + 3ull * M * AW * 2;
constexpr size_t WS_OUTG = WS_VP + 3ull * M * AW * 2;
constexpr size_t WS_LSE = WS_OUTG + 3ull * M * AW * 2;
constexpr size_t WS_OB = WS_LSE + 3ull * M * 8 * 4;
constexpr size_t WS_XSA = WS_OB + (size_t)M * AW * 2;
constexpr size_t WS_XSB = WS_XSA + (size_t)SB * DM * 4;
constexpr size_t WS_RAWA = WS_XSB + (size_t)SB * DM * 4;
constexpr size_t WS_RAWO = WS_RAWA + (size_t)SB * QKVW * 4;
constexpr size_t WS_RAWGU = WS_RAWO + (size_t)SB * DM * 4;
constexpr size_t WS_RAWDN = WS_RAWGU + (size_t)SB * 2 * DFF * 4;
constexpr size_t WS_OS = WS_RAWDN + (size_t)SB * DM * 4;
constexpr size_t WS_ASM = WS_OS + (size_t)SB * AW * 4;
constexpr size_t WS_ASG = WS_ASM + (size_t)SB * DM * 2;
constexpr size_t WS_ADN = WS_ASG + (size_t)SB * DM * 2;
constexpr size_t WS_ZC = WS_ADN + (size_t)SB * DFF * 2;
constexpr size_t WS_BGS = WS_ZC + (size_t)SB * DM * 4;
constexpr size_t WS_SSS = WS_BGS + (size_t)SB * DM * 4;
constexpr size_t WS_SSP = WS_SSS + 8ull * SB * 8;
constexpr size_t WS_GH = WS_SSP + 8ull * M * 8;
constexpr size_t WS_PRE = WS_GH + 64ull * 2 * DFF * 4;
constexpr size_t WS_UH = WS_PRE + 64ull * 2 * DFF * 4;
constexpr size_t WS_BIAS = WS_UH + 64ull * 2 * DFF * 4;
constexpr size_t WS_END = WS_BIAS + 3ull * 8 * 160 * 4;
static_assert(WS_WIN % 256 == 0 && WS_HN % 256 == 0 && WS_QP % 256 == 0 && WS_XSA % 256 == 0 && WS_OS % 256 == 0, "alignment");

constexpr int LDS_BYTES = 147456;
constexpr int LDS_CTL_OFF = 131072;
constexpr int LDS_HALO_OFF = 131072 + 512;
constexpr int LDS_RTAB_OFF = LDS_HALO_OFF + 4096;

#define LAS __attribute__((address_space(3)))
typedef unsigned short bf16;
typedef float f32x4 __attribute__((ext_vector_type(4)));
typedef float f32x16 __attribute__((ext_vector_type(16)));
typedef short bf16x8 __attribute__((ext_vector_type(8)));
typedef short s16x4 __attribute__((ext_vector_type(4)));
typedef unsigned u32x4 __attribute__((ext_vector_type(4)));
typedef unsigned u32x2 __attribute__((ext_vector_type(2)));
typedef short v4i16_t __attribute__((ext_vector_type(4)));

__device__ __forceinline__ unsigned cvtpk(float lo, float hi) { return pg8::cvt_pk_bf16(lo, hi); }
__device__ __forceinline__ float bflo(unsigned w) { return __uint_as_float(w << 16); }
__device__ __forceinline__ float bfhi(unsigned w) { return __uint_as_float(w & 0xffff0000u); }
template <int MASK> __device__ __forceinline__ float sx(float v) { return __int_as_float(__builtin_amdgcn_ds_swizzle(__float_as_int(v), (MASK << 10) | 0x1f)); }
__device__ __forceinline__ float add32(float v) { const auto r = __builtin_amdgcn_permlane32_swap(__float_as_uint(v), __float_as_uint(v), false, false); return __uint_as_float(r[0]) + __uint_as_float(r[1]); }
__device__ __forceinline__ float max32(float v) { const auto r = __builtin_amdgcn_permlane32_swap(__float_as_uint(v), __float_as_uint(v), false, false); return fmaxf(__uint_as_float(r[0]), __uint_as_float(r[1])); }
__device__ __forceinline__ float wave_sum(float v) { v += sx<1>(v); v += sx<2>(v); v += sx<4>(v); v += sx<8>(v); v += sx<16>(v); return add32(v); }
__device__ __forceinline__ float wave_max(float v) { v = fmaxf(v, sx<1>(v)); v = fmaxf(v, sx<2>(v)); v = fmaxf(v, sx<4>(v)); v = fmaxf(v, sx<8>(v)); v = fmaxf(v, sx<16>(v)); return max32(v); }
__device__ __forceinline__ float silu_f(float x) { return x / (1.0f + __expf(-x)); }
__device__ __forceinline__ float silu_fast(float x) { return x * __builtin_amdgcn_rcpf(1.0f + __expf(-x)); }
__device__ __forceinline__ int t5_bucket(int dist) {
    if (dist < 16) return dist;
    double large = 16.0 + log((double)dist / 16.0) / log(128.0) * 16.0;
    int b = (int)floor(large);
    return b > 31 ? 31 : b;
}

struct Ctx {
    LAS unsigned char* lds; int tid, lane, wave, G, bid;
    const float* const* in;
    float* out; unsigned char* ws;
};

struct TItem { const float* W; int K, N; bf16* WT; int drow, k0, n0; const float* gamma; };
__device__ __forceinline__ void transpose_issue(const TItem& t, int lane, f32x4 (&v)[8]) {
#pragma unroll
    for (int i = 0; i < 8; ++i) { const int kk = (lane >> 3) + 8 * i; v[i] = __builtin_nontemporal_load((const f32x4*)(t.W + (size_t)(t.k0 + kk) * t.N + t.n0 + 4 * (lane & 7))); }
}
__device__ __forceinline__ void transpose_finish(const TItem& t, int lane, const f32x4 (&v)[8], LAS float* scr) {
#pragma unroll
    for (int i = 0; i < 8; ++i) { const int kk = (lane >> 3) + 8 * i; f32x4 w = v[i]; if (t.gamma) w *= t.gamma[t.k0 + kk];
        LAS float* d = scr + kk * 33 + 4 * (lane & 7); d[0] = w[0]; d[1] = w[1]; d[2] = w[2]; d[3] = w[3]; }
    asm volatile("s_waitcnt lgkmcnt(0)" ::: "memory");
    const int c = lane & 7;
#pragma unroll
    for (int j = 0; j < 4; ++j) { const int n = (lane >> 3) + 8 * j; const LAS float* s = scr + (8 * c) * 33 + n;
        u32x4 o; o.x = cvtpk(s[0 * 33], s[1 * 33]); o.y = cvtpk(s[2 * 33], s[3 * 33]); o.z = cvtpk(s[4 * 33], s[5 * 33]); o.w = cvtpk(s[6 * 33], s[7 * 33]);
        *(u32x4*)(t.WT + (size_t)(t.drow + n) * t.K + t.k0 + 8 * c) = o; }
    asm volatile("s_waitcnt lgkmcnt(0)" ::: "memory");
}
__host__ __device__ __forceinline__ int drow_in(int n0) {
    if (n0 < 1024) return 2048 + n0;
    if (n0 < 2048) { const int c = n0 - 1024; return 256 * (c >> 7) + (c & 127); }
    const int c = n0 - 2048; return 256 * (c >> 7) + 128 + (c & 127);
}
__host__ __device__ __forceinline__ int drow_qkv(int n0) {
    const int tile = n0 >> 8, hh = (n0 & 255) >> 6, dd = n0 & 63;
    return 256 * tile + 128 * (dd >> 5) + 32 * hh + (dd & 31);
}
__host__ __device__ __forceinline__ int drow_gu(int n0, int up) { return 256 * (n0 >> 7) + 128 * up + (n0 & 127); }

template <int KEEP> __device__ __forceinline__ void shift_copy_range(const float* src, float* dst, long lo, long hi, int tid) {
    constexpr unsigned PER = (unsigned)(KEEP - 1) * 256u;
    constexpr int UNR = 8;
    for (long i0 = lo + tid; i0 < hi; i0 += UNR * NTHR) { f32x4 v[UNR]; unsigned e[UNR];
#pragma unroll
        for (int q = 0; q < UNR; ++q) { const long i = i0 + q * NTHR; const unsigned ii = (unsigned)(i < hi ? i : hi - 1), seg = ii / PER, off = ii % PER;
            e[q] = seg * (unsigned)(KEEP * 256) + off; v[q] = __builtin_nontemporal_load((const f32x4*)src + 256 + e[q]); }
#pragma unroll
        for (int q = 0; q < UNR; ++q) if (i0 + q * NTHR < hi) __builtin_nontemporal_store(v[q], (f32x4*)dst + e[q]); }
}
constexpr long CP_T1 = 64l * 127 * 256, CP_T4 = 64l * 511 * 256, CP_T16 = 64l * 2047 * 256, CP_TOT = CP_T1 + CP_T4 + CP_T16;
constexpr long CP_CH = 16384;
constexpr int CP_NCH = (int)((CP_TOT + CP_CH - 1) / CP_CH);
constexpr int CW_SGU = 4224;
constexpr int CW_CPNEXT = 3584, CW_DONE = 3648;
__device__ __forceinline__ void copy_chunk(const Ctx& F, int c) {
    const long lo = (long)c * CP_CH, hi = lo + CP_CH < CP_TOT ? lo + CP_CH : CP_TOT;
    { const long l = lo, h = hi < CP_T1 ? hi : CP_T1; if (l < h) shift_copy_range<128>(F.in[3], F.out + O_SK1, l, h, F.tid); }
    { const long l = (lo > CP_T1 ? lo : CP_T1) - CP_T1, h = (hi < CP_T1 + CP_T4 ? hi : CP_T1 + CP_T4) - CP_T1; if (l < h) shift_copy_range<512>(F.in[4], F.out + O_SK4, l, h, F.tid); }
    { const long l = (lo > CP_T1 + CP_T4 ? lo : CP_T1 + CP_T4) - (CP_T1 + CP_T4), h = hi - (CP_T1 + CP_T4); if (l < h) shift_copy_range<2048>(F.in[5], F.out + O_SK16, l, h, F.tid); }
}
__device__ __forceinline__ void copy_while(const Ctx& F, int phase_slot, unsigned ngemm) {
    unsigned* ctl = (unsigned*)F.ws; LAS int* tk = (LAS int*)(F.lds + LDS_CTL_OFF + 64);
    for (;;) {
        __syncthreads();
        if (F.tid == 0) { int c = -1;
            const unsigned d = ngemm == ~0u ? 0u : __hip_atomic_load(ctl + CW_DONE + 64 * phase_slot, __ATOMIC_RELAXED, __HIP_MEMORY_SCOPE_AGENT);
            if (d < ngemm) { c = (int)__hip_atomic_fetch_add(ctl + CW_CPNEXT, 1u, __ATOMIC_RELAXED, __HIP_MEMORY_SCOPE_AGENT); if (c >= CP_NCH) c = -1; }
            *tk = c; }
        __syncthreads();
        const int c = *tk; if (c < 0) break;
        copy_chunk(F, c);
    }
}
__device__ __forceinline__ void gemm_done(const Ctx& F, int phase_slot) {
    __syncthreads(); if (F.tid == 0) __hip_atomic_fetch_add((unsigned*)F.ws + CW_DONE + 64 * phase_slot, 1u, __ATOMIC_RELAXED, __HIP_MEMORY_SCOPE_AGENT);
}

typedef unsigned long long u64;
__device__ __forceinline__ u64 ss_fix(float ss) { return (u64)(ss * 4294967296.0f); }
__device__ __forceinline__ void norm_row(const float* xrow, const float* gamma, bf16* orow, unsigned long long* ss, int lane) {
    const f32x4* xr = (const f32x4*)xrow + lane; (void)gamma;
    f32x4 v[4]; float s = 0.f;
#pragma unroll
    for (int j = 0; j < 4; ++j) { v[j] = xr[64 * j]; s += (v[j].x * v[j].x + v[j].y * v[j].y) + (v[j].z * v[j].z + v[j].w * v[j].w); }
    s = wave_sum(s); if (lane == 0) *ss = ss_fix(s);
    u32x2* o8 = (u32x2*)orow + lane;
#pragma unroll
    for (int j = 0; j < 4; ++j) { u32x2 w; w.x = cvtpk(v[j].x, v[j].y); w.y = cvtpk(v[j].z, v[j].w); o8[64 * j] = w; }
}
__device__ __forceinline__ float rs_of(const u64* p) { const float ss = (float)(*p) * 2.3283064365386963e-10f; return 1.0f / sqrtf(ss * (1.0f / DM) + EPS); }
__device__ __forceinline__ void prologue_phase(const Ctx& F) {
    LAS float* scr = (LAS float*)(F.lds + F.wave * 16384);
    const int gw = F.bid * NWAVES + F.wave, NGW = F.G * NWAVES;
    constexpr int I_IN = 16 * 96, I_OUT = 16 * 32, I_QKV = 16 * 144, I_AO = 8 * 32, I_G = 16 * 88, I_DN = 44 * 32;
    constexpr int T_IN = 2 * I_IN, T_OUT = 2 * I_OUT, T_QKV = 2 * I_QKV, T_AO = 2 * I_AO, T_G = 4 * I_G, T_DN = 4 * I_DN;
    constexpr int NITEMS = T_IN + T_OUT + T_QKV + T_AO + 2 * T_G + T_DN;
    auto decode = [&](int it) -> TItem { TItem t; int r = it; t.gamma = nullptr;
        if (r < T_IN) { const int l = r / I_IN, q = r % I_IN, kb = q / 96, nb = q % 96; t.W = F.in[9] + (size_t)l * 1024 * 3072; t.K = 1024; t.N = 3072; t.WT = (bf16*)(F.ws + WS_WIN) + (size_t)l * 3072 * 1024; t.drow = drow_in(32 * nb); t.k0 = 64 * kb; t.n0 = 32 * nb; t.gamma = F.in[7] + (size_t)(2 * l) * DM; return t; } r -= T_IN;
        if (r < T_OUT) { const int l = r / I_OUT, q = r % I_OUT, kb = q / 32, nb = q % 32; t.W = F.in[11] + (size_t)l * 1024 * 1024; t.K = 1024; t.N = 1024; t.WT = (bf16*)(F.ws + WS_WOUT) + (size_t)l * 1024 * 1024; t.drow = 32 * nb; t.k0 = 64 * kb; t.n0 = 32 * nb; return t; } r -= T_OUT;
        if (r < T_QKV) { const int l = r / I_QKV, q = r % I_QKV, kb = q / 144, nb = q % 144; t.W = F.in[12] + (size_t)l * 1024 * 4608; t.K = 1024; t.N = 4608; t.WT = (bf16*)(F.ws + WS_WQKV) + (size_t)l * 4608 * 1024; t.drow = drow_qkv(32 * nb); t.k0 = 64 * kb; t.n0 = 32 * nb; t.gamma = F.in[7] + (size_t)(2 * l + 1) * DM; return t; } r -= T_QKV;
        if (r < T_AO) { const int l = r / I_AO, q = r % I_AO, kb = q / 32, nb = q % 32; t.W = F.in[15] + (size_t)l * 512 * 1024; t.K = 512; t.N = 1024; t.WT = (bf16*)(F.ws + WS_WAO) + (size_t)l * 1024 * 512; t.drow = 32 * nb; t.k0 = 64 * kb; t.n0 = 32 * nb; return t; } r -= T_AO;
        if (r < 2 * T_G) { const int up = r >= T_G ? 1 : 0; r -= up * T_G; const int l = r / I_G, q = r % I_G, kb = q / 88, nb = q % 88; t.W = F.in[17 + up] + (size_t)l * 1024 * 2816; t.K = 1024; t.N = 2816; t.WT = (bf16*)(F.ws + WS_WGU) + (size_t)l * 5632 * 1024; t.drow = drow_gu(32 * nb, up); t.k0 = 64 * kb; t.n0 = 32 * nb; t.gamma = F.in[8] + (size_t)l * DM; return t; } r -= 2 * T_G;
        { const int l = r / I_DN, q = r % I_DN, kb = q / 32, nb = q % 32; t.W = F.in[21] + (size_t)l * 2816 * 1024; t.K = 2816; t.N = 1024; t.WT = (bf16*)(F.ws + WS_WDN) + (size_t)l * 1024 * 2816; t.drow = 32 * nb; t.k0 = 64 * kb; t.n0 = 32 * nb; return t; } };
    if (gw < NITEMS) { TItem cur = decode(gw); f32x4 va[8]; transpose_issue(cur, F.lane, va);
        for (int it = gw; it < NITEMS; it += NGW) { const bool more = it + NGW < NITEMS; TItem nxt = cur; f32x4 vb[8];
            if (more) { nxt = decode(it + NGW); transpose_issue(nxt, F.lane, vb); }
            transpose_finish(cur, F.lane, va, scr);
            if (more) { cur = nxt;
#pragma unroll
                for (int q = 0; q < 8; ++q) va[q] = vb[q]; } } }
    { f32x4 va[4], vb[4];
      if (gw < M) {
#pragma unroll
          for (int q = 0; q < 4; ++q) va[q] = __builtin_nontemporal_load((const f32x4*)(F.in[0] + (size_t)gw * DM) + F.lane + 64 * q);
          for (int m = gw; m < M; m += NGW) { const bool more = m + NGW < M;
              if (more) {
#pragma unroll
                  for (int q = 0; q < 4; ++q) vb[q] = __builtin_nontemporal_load((const f32x4*)(F.in[0] + (size_t)(m + NGW) * DM) + F.lane + 64 * q); }
              float sacc = 0.f;
#pragma unroll
              for (int q = 0; q < 4; ++q) sacc += (va[q].x * va[q].x + va[q].y * va[q].y) + (va[q].z * va[q].z + va[q].w * va[q].w);
              sacc = wave_sum(sacc); if (F.lane == 0) ((unsigned long long*)(F.ws + WS_SSP))[m] = ss_fix(sacc);
              u32x2* o8 = (u32x2*)((bf16*)(F.ws + WS_HN) + (size_t)m * DM) + F.lane;
#pragma unroll
              for (int q = 0; q < 4; ++q) { u32x2 w; w.x = cvtpk(va[q].x, va[q].y); w.y = cvtpk(va[q].z, va[q].w); o8[64 * q] = w; }
              if (more) {
#pragma unroll
                  for (int q = 0; q < 4; ++q) va[q] = vb[q]; } } } }
    { const size_t gt0 = (size_t)F.bid * NTHR + F.tid, ngt0 = (size_t)F.G * NTHR; unsigned long long* ssp = (unsigned long long*)(F.ws + WS_SSP) + M;
      for (size_t e = gt0; e < 7ull * M; e += ngt0) ssp[e] = 0ull; }
    { const int gw2 = F.bid * NWAVES + F.wave;
      if (gw2 < SB) { const int row = gw2; const f32x4* xr = (const f32x4*)(F.in[1] + (size_t)row * DM) + F.lane; float sacc = 0.f;
          u32x2* o8 = (u32x2*)((bf16*)(F.ws + WS_ASM) + (size_t)row * DM) + F.lane;
#pragma unroll
          for (int q = 0; q < 4; ++q) { const f32x4 v = xr[64 * q]; sacc += (v.x * v.x + v.y * v.y) + (v.z * v.z + v.w * v.w); u32x2 w; w.x = cvtpk(v.x, v.y); w.y = cvtpk(v.z, v.w); o8[64 * q] = w; }
          sacc = wave_sum(sacc); if (F.lane == 0) ((unsigned long long*)(F.ws + WS_SSS))[row] = ss_fix(sacc); }
      if (F.bid == 0 && F.tid >= SB && F.tid < 8 * SB) ((unsigned long long*)(F.ws + WS_SSS))[F.tid] = 0ull; }
    if (F.tid < 15) { const int e = F.bid * 15 + F.tid;
        if (e < 3 * 8 * 160) { const int g = e / 1280, h = (e / 160) & 7, jj = e % 160 - 16;
            ((float*)(F.ws + WS_BIAS))[e] = (jj >= 0 && jj <= 128) ? F.in[16][t5_bucket((1 << (2 * g)) * jj) * 24 + g * 8 + h] : NEGF; } }
    if (F.G * 15 < 3 * 8 * 160 && F.bid == 0) for (int e = F.G * 15 + F.tid; e < 3 * 8 * 160; e += NTHR) { const int g = e / 1280, h = (e / 160) & 7, jj = e % 160 - 16;
        ((float*)(F.ws + WS_BIAS))[e] = (jj >= 0 && jj <= 128) ? F.in[16][t5_bucket((1 << (2 * g)) * jj) * 24 + g * 8 + h] : NEGF; }
}

__device__ __forceinline__ void preload_rtab(const Ctx& F, const pg8::StaticOrder& S, const u64* ssp) {
    LAS float* rt = (LAS float*)(F.lds + LDS_RTAB_OFF);
    if (F.tid < 256) { u64 v[6]; bool ok[6];
#pragma unroll
        for (int i = 0; i < 6; ++i) { pg8::Unit u; ok[i] = S.next(i, u); v[i] = ok[i] ? ssp[u.pm * 256 + F.tid] : 0ull; }
#pragma unroll
        for (int i = 0; i < 6; ++i) if (ok[i]) rt[i * 256 + F.tid] = 1.0f / sqrtf((float)v[i] * 2.3283064365386963e-10f * (1.0f / DM) + EPS); }
    __syncthreads();
}
using pg8::Unit;
typedef f32x4 AccT[2][2][4][2];
__device__ __forceinline__ u32x4 pack8(const f32x4& a, const f32x4& b) { u32x4 w; w.x = cvtpk(a[0], a[1]); w.y = cvtpk(a[2], a[3]); w.z = cvtpk(b[0], b[1]); w.w = cvtpk(b[2], b[3]); return w; }

struct EpiIn {
    static constexpr bool PERM = true, AFTER_DRAIN = false, APERM = false;
    bf16* Z; bf16* BG; float* psc; const LAS float* rt;
    __device__ __forceinline__ void operator()(const f32x4 (&acc)[2][2][4][2], const Unit& u, int wr, int wc, int fr, int fq, int ui) const {
        const int row0 = u.pm * 256 + wr * 64 + fr;
        if (u.pn < 8) {
            const int ch = u.pn * 128 + wc * 32 + 8 * fq;
#pragma unroll
            for (int ai = 0; ai < 2; ++ai)
#pragma unroll
                for (int m = 0; m < 4; ++m) { const int row = row0 + ai * 128 + m * 16; const float r = rt[ui * 256 + (row & 255)], r2 = r * r;
                    const f32x4 z0 = (acc[ai][0][m][0] * acc[ai][1][m][0]) * r2, z1 = (acc[ai][0][m][1] * acc[ai][1][m][1]) * r2;
                    *(u32x4*)(Z + (size_t)row * DM + ch) = pack8(z0, z1);
                    const int t = row & (SEQ - 1);
                    if (t >= SEQ - 2) { float* p = psc + ((size_t)(row >> 12) * 2 + (t - (SEQ - 2))) * DM + ch; *(f32x4*)p = z0; *(f32x4*)(p + 4) = z1; } }
        } else {
#pragma unroll
            for (int ai = 0; ai < 2; ++ai)
#pragma unroll
                for (int m = 0; m < 4; ++m) { const int row = row0 + ai * 128 + m * 16; const float r = rt[ui * 256 + (row & 255)];
#pragma unroll
                    for (int bj = 0; bj < 2; ++bj) { const int ch = (u.pn - 8) * 256 + bj * 128 + wc * 32 + 8 * fq;
                        *(u32x4*)(BG + (size_t)row * DM + ch) = pack8(acc[ai][bj][m][0] * r, acc[ai][bj][m][1] * r); } }
        }
    }
};
struct EpiRes {
    static constexpr bool PERM = true, AFTER_DRAIN = false, APERM = false;
    const float* xin32; bf16* xb; u64* ss_next; float* yout;
    __device__ __forceinline__ void operator()(const f32x4 (&acc)[2][2][4][2], const Unit& u, int wr, int wc, int fr, int fq, int ui) const {
        const int row0 = u.pm * 256 + wr * 64 + fr, col0 = u.pn * 256 + wc * 32 + 8 * fq;
#pragma unroll
        for (int ai = 0; ai < 2; ++ai) {
            f32x4 x[4][2][2];
            if (xin32) {
#pragma unroll
                for (int m = 0; m < 4; ++m)
#pragma unroll
                    for (int bj = 0; bj < 2; ++bj) { const float* p = xin32 + (size_t)(row0 + ai * 128 + m * 16) * DM + col0 + bj * 128; x[m][bj][0] = __builtin_nontemporal_load((const f32x4*)p); x[m][bj][1] = __builtin_nontemporal_load((const f32x4*)(p + 4)); }
            } else { u32x4 w[4][2];
#pragma unroll
                for (int m = 0; m < 4; ++m)
#pragma unroll
                    for (int bj = 0; bj < 2; ++bj) w[m][bj] = *(const u32x4*)(xb + (size_t)(row0 + ai * 128 + m * 16) * DM + col0 + bj * 128);
#pragma unroll
                for (int m = 0; m < 4; ++m)
#pragma unroll
                    for (int bj = 0; bj < 2; ++bj) { const u32x4 q = w[m][bj]; x[m][bj][0] = (f32x4){bflo(q.x), bfhi(q.x), bflo(q.y), bfhi(q.y)}; x[m][bj][1] = (f32x4){bflo(q.z), bfhi(q.z), bflo(q.w), bfhi(q.w)}; } }
#pragma unroll
            for (int m = 0; m < 4; ++m) { const int row = row0 + ai * 128 + m * 16; const size_t off = (size_t)row * DM + col0; float ss = 0.f;
#pragma unroll
                for (int bj = 0; bj < 2; ++bj) { const f32x4 x0 = x[m][bj][0] + acc[ai][bj][m][0], x1 = x[m][bj][1] + acc[ai][bj][m][1];
                    if (yout) { __builtin_nontemporal_store(x0, (f32x4*)(yout + off + bj * 128)); __builtin_nontemporal_store(x1, (f32x4*)(yout + off + bj * 128 + 4)); }
                    else { *(u32x4*)(xb + off + bj * 128) = pack8(x0, x1);
                        ss += (x0[0] * x0[0] + x0[1] * x0[1]) + (x0[2] * x0[2] + x0[3] * x0[3]) + (x1[0] * x1[0] + x1[1] * x1[1]) + (x1[2] * x1[2] + x1[3] * x1[3]); } }
                if (!yout) { ss += sx<16>(ss); ss = add32(ss); if (fq == 0) atomicAdd(ss_next + row, ss_fix(ss)); } }
            asm volatile("" ::: "memory"); }
    }
};
struct EpiGU {
    static constexpr bool PERM = true, AFTER_DRAIN = false, APERM = false;
    bf16* GB; bf16* UPB; float* pffn; const u64* ssp;
    __device__ __forceinline__ void operator()(const f32x4 (&acc)[2][2][4][2], const Unit& u, int wr, int wc, int fr, int fq, int ui) const {
        const int row0 = u.pm * 256 + wr * 64 + fr, ch = u.pn * 128 + wc * 32 + 8 * fq;
#pragma unroll
        for (int ai = 0; ai < 2; ++ai)
#pragma unroll
            for (int m = 0; m < 4; ++m) { const int row = row0 + ai * 128 + m * 16; const float r = rs_of(ssp + row);
                const f32x4 g0 = acc[ai][0][m][0] * r, g1 = acc[ai][0][m][1] * r;
                *(u32x4*)(GB + (size_t)row * DFF + ch) = pack8(g0, g1);
                *(u32x4*)(UPB + (size_t)row * DFF + ch) = pack8(acc[ai][1][m][0] * r, acc[ai][1][m][1] * r);
                const int t = row & (SEQ - 1);
                if (t >= SEQ - 2) { float* p = pffn + ((size_t)(row >> 12) * 2 + (t - (SEQ - 2))) * DFF + ch; *(f32x4*)p = g0; *(f32x4*)(p + 4) = g1; } }
    }
};
struct EpiQKV {
    static constexpr bool PERM = true, AFTER_DRAIN = false, APERM = false;
    bf16* QP; const float* qn; long kdiff; float* outp; int j; const LAS float* rt;
    __device__ __forceinline__ void operator()(const f32x4 (&acc)[2][2][4][2], const Unit& u, int wr, int wc, int fr, int fq, int ui) const {
        const int g = u.pn / 6, s = (u.pn % 6) >> 1, h = 4 * (u.pn & 1) + wc;
        const int lg = 2 * g, dil = 1 << lg, Lg = SEQ >> lg, keep = 128 << lg;
        const int row0 = u.pm * 256 + wr * 64 + fr;
        bf16* dstb = QP + (size_t)s * (3ull * M * AW);
        const size_t pkoff = (g == 0 ? O_PK1 : (g == 1 ? O_PK4 : O_PK16)) + (size_t)j * NBATCH * keep * 1024;
        float* pk = outp + pkoff;
        f32x4 w[2][2];
        { const float* nw = qn + (s == 1 ? kdiff : 0l);
#pragma unroll
            for (int bj = 0; bj < 2; ++bj)
#pragma unroll
                for (int n = 0; n < 2; ++n) w[bj][n] = *(const f32x4*)(nw + 32 * bj + 8 * fq + 4 * n); }
#pragma unroll
        for (int ai = 0; ai < 2; ++ai)
#pragma unroll
            for (int m = 0; m < 4; ++m) { const int row = row0 + ai * 128 + m * 16, b = row >> 12, t = row & (SEQ - 1);
                f32x4 v[2][2]; const float rr = rt[ui * 256 + (row & 255)];
#pragma unroll
                for (int bj = 0; bj < 2; ++bj)
#pragma unroll
                    for (int n = 0; n < 2; ++n) v[bj][n] = acc[ai][bj][m][n] * rr;
                if (s < 2) { float ss = 0.f;
#pragma unroll
                    for (int bj = 0; bj < 2; ++bj)
#pragma unroll
                        for (int n = 0; n < 2; ++n) ss += (v[bj][n][0] * v[bj][n][0] + v[bj][n][1] * v[bj][n][1]) + (v[bj][n][2] * v[bj][n][2] + v[bj][n][3] * v[bj][n][3]);
                    ss += sx<16>(ss); ss = add32(ss);
                    const float r = 1.0f / sqrtf(ss * (1.0f / HD) + EPS);
#pragma unroll
                    for (int bj = 0; bj < 2; ++bj)
#pragma unroll
                        for (int n = 0; n < 2; ++n) v[bj][n] = (v[bj][n] * r) * w[bj][n]; }
                const int res = t & (dil - 1), tt = t >> lg;
                const size_t prow = (size_t)((g * NBATCH + b) * NH + h) * SEQ + (size_t)res * Lg + tt;
#pragma unroll
                for (int bj = 0; bj < 2; ++bj) *(u32x4*)(dstb + prow * HD + 32 * bj + 8 * fq) = pack8(v[bj][0], v[bj][1]);
                if (s >= 1 && t >= SEQ - keep) {
                    float* p = pk + ((((size_t)b * keep + (t - (SEQ - keep))) * 2 + (s - 1)) * NH + h) * HD + 8 * fq;
#pragma unroll
                    for (int bj = 0; bj < 2; ++bj)
#pragma unroll
                        for (int n = 0; n < 2; ++n) __builtin_nontemporal_store(v[bj][n], (f32x4*)(p + 32 * bj + 4 * n)); } }
    }
};

__device__ __forceinline__ float dpp_shr1(float old, float src) { return __int_as_float(__builtin_amdgcn_update_dpp(__float_as_int(old), __float_as_int(src), 0x111, 0xf, 0xf, false)); }
__device__ __forceinline__ float dpp_shr2(float old, float src) { return __int_as_float(__builtin_amdgcn_update_dpp(__float_as_int(old), __float_as_int(src), 0x112, 0xf, 0xf, false)); }
__device__ __forceinline__ float dpp_ror1(float src) { return __int_as_float(__builtin_amdgcn_update_dpp(0, __float_as_int(src), 0x121, 0xf, 0xf, false)); }
__device__ __forceinline__ float dpp_ror2(float src) { return __int_as_float(__builtin_amdgcn_update_dpp(0, __float_as_int(src), 0x122, 0xf, 0xf, false)); }
struct EpiGUF {
    static constexpr bool PERM = true, AFTER_DRAIN = false, APERM = true;
    bf16* ACT; float* pffn; const LAS float* rt; const float* cw; const float* cb; float* GH; float* PRE; float* UH; LAS float* halo;
    __device__ __forceinline__ void operator()(const f32x4 (&acc)[2][2][4][2], const Unit& u, int wr, int wc, int fr, int fq, int ui) const {
        const int row0 = u.pm * 256 + wr * 64 + 4 * fr, ch = u.pn * 128 + wc * 32 + 8 * fq;
        f32x4 w0[2], w1[2], w2[2], bb[2];
#pragma unroll
        for (int n = 0; n < 2; ++n) { w0[n] = *(const f32x4*)(cw + ch + 4 * n); w1[n] = *(const f32x4*)(cw + DFF + ch + 4 * n); w2[n] = *(const f32x4*)(cw + 2 * DFF + ch + 4 * n); bb[n] = *(const f32x4*)(cb + ch + 4 * n); }
        f32x4 G[2][4][2], U[2][4][2];
#pragma unroll
        for (int ai = 0; ai < 2; ++ai)
#pragma unroll
            for (int m = 0; m < 4; ++m) { const float r = rt[ui * 256 + wr * 64 + 4 * fr + ai * 128 + m];
#pragma unroll
                for (int n = 0; n < 2; ++n) { G[ai][m][n] = acc[ai][0][m][n] * r; U[ai][m][n] = acc[ai][1][m][n] * r; } }
        if (fr == 15) {
#pragma unroll
            for (int ai = 0; ai < 2; ++ai)
#pragma unroll
                for (int q = 0; q < 2; ++q)
#pragma unroll
                    for (int n = 0; n < 2; ++n) *(LAS f32x4*)(halo + ((((ai * 2 + wr) * 4 + wc) * 4 + fq) * 2 + q) * 8 + 4 * n) = G[ai][2 + q][n];
            if (wr == 1) {
#pragma unroll
                for (int q = 0; q < 2; ++q) { float* gp = GH + ((size_t)u.pm * 2 + q) * DFF + ch; *(f32x4*)gp = G[1][2 + q][0]; *(f32x4*)(gp + 4) = G[1][2 + q][1];
                    if ((u.pm & 15) == 15) { float* p = pffn + ((size_t)(u.pm >> 4) * 2 + q) * DFF + ch; *(f32x4*)p = G[1][2 + q][0]; *(f32x4*)(p + 4) = G[1][2 + q][1]; } } } }
        asm volatile("s_waitcnt lgkmcnt(0)" ::: "memory"); __builtin_amdgcn_s_barrier(); asm volatile("" ::: "memory");
#pragma unroll
        for (int ai = 0; ai < 2; ++ai) {
            f32x4 h63[2], h62[2];
            const bool have = (wr == 1) || (ai == 1);
            const int sai = wr == 1 ? ai : 0, swr = wr == 1 ? 0 : 1;
#pragma unroll
            for (int n = 0; n < 2; ++n) { const LAS float* hp = halo + ((((sai * 2 + swr) * 4 + wc) * 4 + fq) * 2) * 8 + 4 * n;
                const f32x4 r63 = *(const LAS f32x4*)(hp + 8), r62 = *(const LAS f32x4*)(hp);
                h63[n] = have ? r63 : (f32x4){0.f, 0.f, 0.f, 0.f}; h62[n] = have ? r62 : (f32x4){0.f, 0.f, 0.f, 0.f}; }
            f32x4 o[4][2], pr0[2], pr1[2];
#pragma unroll
            for (int n = 0; n < 2; ++n)
#pragma unroll
                for (int e = 0; e < 4; ++e) {
                    const float g0 = G[ai][0][n][e], g1 = G[ai][1][n][e], g2 = G[ai][2][n][e], g3 = G[ai][3][n][e];
                    const float s3 = dpp_shr1(h63[n][e], g3), s2 = dpp_shr1(h62[n][e], g2);
                    const float a = w0[n][e], b = w1[n][e], c = w2[n][e], d = bb[n][e];
                    const float p0 = a * s2 + b * s3 + c * g0 + d, p1 = a * s3 + b * g0 + c * g1 + d, p2 = a * g0 + b * g1 + c * g2 + d, p3 = a * g1 + b * g2 + c * g3 + d;
                    pr0[n][e] = p0; pr1[n][e] = p1;
                    o[0][n][e] = silu_fast(p0) * U[ai][0][n][e]; o[1][n][e] = silu_fast(p1) * U[ai][1][n][e]; o[2][n][e] = silu_fast(p2) * U[ai][2][n][e]; o[3][n][e] = silu_fast(p3) * U[ai][3][n][e]; }
#pragma unroll
            for (int m = 0; m < 4; ++m) *(u32x4*)(ACT + (size_t)(row0 + ai * 128 + m) * DFF + ch) = pack8(o[m][0], o[m][1]);
            if (ai == 0 && wr == 0 && fr == 0) {
                float* pp = PRE + ((size_t)u.pm * 2) * DFF + ch; *(f32x4*)pp = pr0[0]; *(f32x4*)(pp + 4) = pr0[1]; *(f32x4*)(pp + DFF) = pr1[0]; *(f32x4*)(pp + DFF + 4) = pr1[1];
                float* up = UH + ((size_t)u.pm * 2) * DFF + ch; *(f32x4*)up = U[0][0][0]; *(f32x4*)(up + 4) = U[0][0][1]; *(f32x4*)(up + DFF) = U[0][1][0]; *(f32x4*)(up + DFF + 4) = U[0][1][1]; }
        }
    }
};
__device__ __forceinline__ void ffn_fixup_panel(const Ctx& F, int pm, const float* GH, const float* PRE, const float* UH, const float* cw, bf16* ACT) {
    if ((pm & 15) != 0) {
        for (int e = F.tid; e < 2 * 352; e += NTHR) { const int rr = e / 352, c = (e % 352) * 8;
            const float* pp = PRE + ((size_t)pm * 2 + rr) * DFF + c; const float* up = UH + ((size_t)pm * 2 + rr) * DFF + c;
            const float* g0 = GH + ((size_t)(pm - 1) * 2 + 0) * DFF + c; const float* g1 = GH + ((size_t)(pm - 1) * 2 + 1) * DFF + c;
            const f32x4 pa = *(const f32x4*)pp, pb = *(const f32x4*)(pp + 4), ua = *(const f32x4*)up, ub = *(const f32x4*)(up + 4), ga = *(const f32x4*)g1, gb = *(const f32x4*)(g1 + 4);
            const f32x4 w0a = *(const f32x4*)(cw + c), w0b = *(const f32x4*)(cw + c + 4);
            f32x4 xa = pa + w0a * ga, xb = pb + w0b * gb;
            if (rr == 0) { const f32x4 ha = *(const f32x4*)g0, hb = *(const f32x4*)(g0 + 4), w1a = *(const f32x4*)(cw + DFF + c), w1b = *(const f32x4*)(cw + DFF + c + 4);
                xa = pa + w0a * ha + w1a * ga; xb = pb + w0b * hb + w1b * gb; }
            f32x4 oa, ob;
#pragma unroll
            for (int q = 0; q < 4; ++q) { oa[q] = silu_f(xa[q]) * ua[q]; ob[q] = silu_f(xb[q]) * ub[q]; }
            *(u32x4*)(ACT + (size_t)(pm * 256 + rr) * DFF + c) = pack8(oa, ob); }
    }
    asm volatile("s_waitcnt vmcnt(0)" ::: "memory"); __syncthreads();
}

__device__ __forceinline__ void conv_ew_phase(const Ctx& F, const bf16* Z, const bf16* BG, const float* cw  , bf16* UB, int ewid, int ewn) {
    if (ewid < 0) return;
    const size_t gt = (size_t)ewid * NTHR + F.tid, ngt = (size_t)ewn * NTHR;
    const int c = (int)(gt & 127) * 8;
    const f32x4 w0a = *(const f32x4*)(cw + c), w0b = *(const f32x4*)(cw + c + 4), w1a = *(const f32x4*)(cw + DM + c), w1b = *(const f32x4*)(cw + DM + c + 4), w2a = *(const f32x4*)(cw + 2 * DM + c), w2b = *(const f32x4*)(cw + 2 * DM + c + 4);
    constexpr size_t TOT = (size_t)M * 128; constexpr int UN = 4;
    for (size_t i0 = gt; i0 < TOT; i0 += UN * ngt) { u32x4 z2[UN], z1[UN], z0[UN], bg[UN];
#pragma unroll
        for (int q = 0; q < UN; ++q) { const size_t i = i0 + q * ngt < TOT ? i0 + q * ngt : gt; const int row = (int)(i >> 7), t = row & (SEQ - 1);
            z2[q] = *(const u32x4*)(Z + (size_t)row * DM + c); z1[q] = (u32x4){0u, 0u, 0u, 0u}; z0[q] = (u32x4){0u, 0u, 0u, 0u};
            if (t >= 1) z1[q] = *(const u32x4*)(Z + (size_t)(row - 1) * DM + c);
            if (t >= 2) z0[q] = *(const u32x4*)(Z + (size_t)(row - 2) * DM + c);
            bg[q] = *(const u32x4*)(BG + (size_t)row * DM + c); }
#pragma unroll
        for (int q = 0; q < UN; ++q) { const size_t i = i0 + q * ngt; if (i < TOT) { const int row = (int)(i >> 7); float o[8];
#pragma unroll
            for (int p = 0; p < 4; ++p) { const float wl0 = p < 2 ? w0a[2 * p] : w0b[2 * p - 4], wh0 = p < 2 ? w0a[2 * p + 1] : w0b[2 * p - 3];
                const float wl1 = p < 2 ? w1a[2 * p] : w1b[2 * p - 4], wh1 = p < 2 ? w1a[2 * p + 1] : w1b[2 * p - 3];
                const float wl2 = p < 2 ? w2a[2 * p] : w2b[2 * p - 4], wh2 = p < 2 ? w2a[2 * p + 1] : w2b[2 * p - 3];
                o[2 * p] = bflo(bg[q][p]) * (wl0 * bflo(z0[q][p]) + wl1 * bflo(z1[q][p]) + wl2 * bflo(z2[q][p]));
                o[2 * p + 1] = bfhi(bg[q][p]) * (wh0 * bfhi(z0[q][p]) + wh1 * bfhi(z1[q][p]) + wh2 * bfhi(z2[q][p])); }
            u32x4 w; w.x = cvtpk(o[0], o[1]); w.y = cvtpk(o[2], o[3]); w.z = cvtpk(o[4], o[5]); w.w = cvtpk(o[6], o[7]);
            *(u32x4*)(UB + (size_t)row * DM + c) = w; } } }
}
__device__ __forceinline__ void ffn_ew_phase(const Ctx& F, const bf16* GB, const bf16* UPB, const float* cw  , const float* cb, bf16* ACT) {
    const size_t gt = (size_t)F.bid * NTHR + F.tid, ngt = (size_t)F.G * NTHR;
    for (size_t i = gt; i < (size_t)M * 352; i += ngt) { const int row = (int)(i / 352), c = (int)(i % 352) * 8, t = row & (SEQ - 1);
        const u32x4 g2 = *(const u32x4*)(GB + (size_t)row * DFF + c);
        u32x4 g1 = (u32x4){0u, 0u, 0u, 0u}, g0 = (u32x4){0u, 0u, 0u, 0u};
        if (t >= 1) g1 = *(const u32x4*)(GB + (size_t)(row - 1) * DFF + c);
        if (t >= 2) g0 = *(const u32x4*)(GB + (size_t)(row - 2) * DFF + c);
        const u32x4 up = *(const u32x4*)(UPB + (size_t)row * DFF + c);
        float w0[8], w1[8], w2[8], bb[8];
        *(f32x4*)(w0) = *(const f32x4*)(cw + c); *(f32x4*)(w0 + 4) = *(const f32x4*)(cw + c + 4);
        *(f32x4*)(w1) = *(const f32x4*)(cw + DFF + c); *(f32x4*)(w1 + 4) = *(const f32x4*)(cw + DFF + c + 4);
        *(f32x4*)(w2) = *(const f32x4*)(cw + 2 * DFF + c); *(f32x4*)(w2 + 4) = *(const f32x4*)(cw + 2 * DFF + c + 4);
        *(f32x4*)(bb) = *(const f32x4*)(cb + c); *(f32x4*)(bb + 4) = *(const f32x4*)(cb + c + 4);
        float o[8];
#pragma unroll
        for (int q = 0; q < 4; ++q) {
            const float a = w0[2 * q] * bflo(g0[q]) + w1[2 * q] * bflo(g1[q]) + w2[2 * q] * bflo(g2[q]) + bb[2 * q];
            const float b = w0[2 * q + 1] * bfhi(g0[q]) + w1[2 * q + 1] * bfhi(g1[q]) + w2[2 * q + 1] * bfhi(g2[q]) + bb[2 * q + 1];
            o[2 * q] = silu_f(a) * bflo(up[q]); o[2 * q + 1] = silu_f(b) * bfhi(up[q]); }
        u32x4 w; w.x = cvtpk(o[0], o[1]); w.y = cvtpk(o[2], o[3]); w.z = cvtpk(o[4], o[5]); w.w = cvtpk(o[6], o[7]);
        *(u32x4*)(ACT + (size_t)row * DFF + c) = w; }
}
__device__ __forceinline__ void merge_phase(const Ctx& F, const bf16* OUTG, const float* LSE, bf16* OB, int ewid, int ewn) {
    if (ewid < 0) return;
    const size_t gt = (size_t)ewid * NTHR + F.tid, ngt = (size_t)ewn * NTHR;
    const int c = (int)(gt & 63) * 8, h = c >> 6;
    constexpr size_t TOT = (size_t)M * 64; constexpr int UN = 3;
    for (size_t i0 = gt; i0 < TOT; i0 += UN * ngt) { float l0[UN], l1[UN], l2[UN]; u32x4 a[UN], b[UN], d[UN];
#pragma unroll
        for (int q = 0; q < UN; ++q) { const size_t i = i0 + q * ngt < TOT ? i0 + q * ngt : gt; const int row = (int)(i >> 6);
            l0[q] = LSE[(size_t)row * 8 + h]; l1[q] = LSE[((size_t)M + row) * 8 + h]; l2[q] = LSE[((size_t)2 * M + row) * 8 + h];
            a[q] = *(const u32x4*)(OUTG + (size_t)row * AW + c); b[q] = *(const u32x4*)(OUTG + ((size_t)M + row) * AW + c); d[q] = *(const u32x4*)(OUTG + ((size_t)2 * M + row) * AW + c); }
#pragma unroll
        for (int q = 0; q < UN; ++q) { const size_t i = i0 + q * ngt; if (i < TOT) { const int row = (int)(i >> 6);
            const float mx = fmaxf(l0[q], fmaxf(l1[q], l2[q])); float e0 = __expf(l0[q] - mx), e1 = __expf(l1[q] - mx), e2 = __expf(l2[q] - mx); const float inv = 1.0f / (e0 + e1 + e2); e0 *= inv; e1 *= inv; e2 *= inv;
            u32x4 w;
#pragma unroll
            for (int p = 0; p < 4; ++p) w[p] = cvtpk(e0 * bflo(a[q][p]) + e1 * bflo(b[q][p]) + e2 * bflo(d[q][p]), e0 * bfhi(a[q][p]) + e1 * bfhi(b[q][p]) + e2 * bfhi(d[q][p]));
            *(u32x4*)(OB + (size_t)row * AW + c) = w; } } }
}

constexpr int KV_ROWB = 144;
constexpr int LDS_VS = 384 * KV_ROWB, LDS_TAB = 2 * LDS_VS;
__device__ __forceinline__ s16x4 vtr(const LAS unsigned char* p) { return __builtin_bit_cast(s16x4, __builtin_amdgcn_ds_read_tr16_b64_v4i16((LAS v4i16_t*)p)); }
struct AttnItem { int g, b, h, res, c, lg, tt0; size_t rowbase; };
__device__ __forceinline__ AttnItem attn_decode(int item) {
    AttnItem t; t.g = item >> 9; const int rem = item & 511, bh = rem >> 4, sub = rem & 15; t.b = bh >> 3; t.h = bh & 7; t.lg = 2 * t.g;
    t.res = t.g == 0 ? 0 : (t.g == 1 ? (sub >> 2) : sub); t.c = t.g == 0 ? sub : (t.g == 1 ? (sub & 3) : 0);
    t.rowbase = (size_t)((t.g * NBATCH + t.b) * NH + t.h) * SEQ + (size_t)t.res * (SEQ >> t.lg); t.tt0 = t.c * 256; return t;
}
__device__ __forceinline__ void attn_issue(const AttnItem& t, const bf16* KP, const bf16* VP, int tid, u32x4 (&kr)[6], u32x4 (&vr)[6], const bf16* QP, const float* biasw, bf16x8 (&qf)[2][2], float& tabv) {
    { const int lane = tid & 63, wave = tid >> 6, qi = lane & 15, grp = lane >> 4;
#pragma unroll
      for (int q2 = 0; q2 < 2; ++q2) { const bf16* qrow = QP + (t.rowbase + t.tt0 + 16 * (wave * 2 + q2) + qi) * HD; qf[q2][0] = *(const bf16x8*)(qrow + 8 * grp); qf[q2][1] = *(const bf16x8*)(qrow + 32 + 8 * grp); }
      tabv = biasw[(t.g * 8 + t.h) * 160 + (tid < 160 ? tid : 0)]; }
#pragma unroll
    for (int q = 0; q < 6; ++q) { const int idx = tid + q * NTHR, r = idx >> 3, ch = idx & 7, tt = t.tt0 - 128 + r;
        kr[q] = (u32x4){0u, 0u, 0u, 0u}; vr[q] = (u32x4){0u, 0u, 0u, 0u};
        if (tt >= 0) { kr[q] = *(const u32x4*)(KP + (t.rowbase + tt) * HD + ch * 8); vr[q] = *(const u32x4*)(VP + (t.rowbase + tt) * HD + ch * 8); } }
}
__device__ __forceinline__ void attn_phase(const Ctx& F, const bf16* QP, const bf16* KP, const bf16* VP, bf16* OUTG, float* LSE) {
    LAS float* tab = (LAS float*)(F.lds + LDS_TAB);
    const int lane = F.lane, qi = lane & 15, grp = lane >> 4;
    u32x4 kr[6], vr[6]; bf16x8 qnx[2][2]; float tabv = 0.f;
    const float* biasw = (const float*)(F.ws + WS_BIAS);
    if (F.bid < 1536) { const AttnItem t0 = attn_decode(F.bid); attn_issue(t0, KP, VP, F.tid, kr, vr, QP, biasw, qnx, tabv); }
    for (int item = F.bid; item < 1536; item += F.G) {
        const AttnItem t = attn_decode(item);
        const int g = t.g, b = t.b, h = t.h, res = t.res, c = t.c, lg = t.lg, dil = 1 << lg, tt0 = t.tt0; const size_t rowbase = t.rowbase;
        __syncthreads();
#pragma unroll
        for (int q = 0; q < 6; ++q) { const int idx = F.tid + q * NTHR, r = idx >> 3, ch = idx & 7;
            *(LAS u32x4*)(F.lds + r * KV_ROWB + ch * 16) = kr[q]; *(LAS u32x4*)(F.lds + LDS_VS + r * KV_ROWB + ch * 16) = vr[q]; }
        if (F.tid < 160) tab[F.tid] = tabv * 1.4426950408889634f;
        __syncthreads();
        bf16x8 qfa[2][2];
#pragma unroll
        for (int q2 = 0; q2 < 2; ++q2) { qfa[q2][0] = qnx[q2][0]; qfa[q2][1] = qnx[q2][1]; }
        if (item + F.G < 1536) { const AttnItem tn = attn_decode(item + F.G); attn_issue(tn, KP, VP, F.tid, kr, vr, QP, biasw, qnx, tabv); }
#pragma unroll
        for (int q2 = 0; q2 < 2; ++q2) {
            const int qt = F.wave * 2 + q2, tq = tt0 + 16 * qt + qi;
            const bf16x8 qf0 = qfa[q2][0], qf1 = qfa[q2][1];
            f32x4 s[9];
            const LAS unsigned char* kbase = F.lds + (16 * qt + qi) * KV_ROWB + grp * 16;
#pragma unroll
            for (int kb = 0; kb < 9; ++kb) {
                const bf16x8 k0 = *(const LAS bf16x8*)(kbase + kb * 16 * KV_ROWB), k1 = *(const LAS bf16x8*)(kbase + kb * 16 * KV_ROWB + 64);
                f32x4 z = (f32x4){0.f, 0.f, 0.f, 0.f};
                z = __builtin_amdgcn_mfma_f32_16x16x32_bf16(k0, qf0, z, 0, 0, 0);
                s[kb] = __builtin_amdgcn_mfma_f32_16x16x32_bf16(k1, qf1, z, 0, 0, 0); }
            float bv[9][4];
#pragma unroll
            for (int kb = 0; kb < 9; ++kb)
#pragma unroll
                for (int r = 0; r < 4; ++r) bv[kb][r] = tab[qi + 144 - (16 * kb + 4 * grp + r)];
            float mx = -3.0e38f;
#pragma unroll
            for (int kb = 0; kb < 9; ++kb)
#pragma unroll
                for (int r = 0; r < 4; ++r) s[kb][r] = fmaf(s[kb][r], 0.125f * 1.4426950408889634f, bv[kb][r]);
            { const float limf = c == 0 ? (float)(128 - 16 * qt - 4 * grp) : -1.0e9f;
#pragma unroll
              for (int kb = 0; kb < 9; ++kb)
#pragma unroll
                  for (int r = 0; r < 4; ++r) s[kb][r] = fmaf(__builtin_amdgcn_fmed3f(limf - (float)(16 * kb + r), 0.f, 1.f), NEGF, s[kb][r]); }
#pragma unroll
            for (int kb = 0; kb < 9; ++kb) mx = fmaxf(mx, fmaxf(fmaxf(s[kb][0], s[kb][1]), fmaxf(s[kb][2], s[kb][3])));
            mx = fmaxf(mx, sx<16>(mx)); mx = max32(mx);
            float sum = 0.f;
#pragma unroll
            for (int kb = 0; kb < 9; ++kb)
#pragma unroll
                for (int r = 0; r < 4; ++r) { const float p = __builtin_amdgcn_exp2f(s[kb][r] - mx); s[kb][r] = p; sum += p; }
            sum += sx<16>(sum); sum = add32(sum);
            f32x4 o[4];
#pragma unroll
            for (int d = 0; d < 4; ++d) o[d] = (f32x4){0.f, 0.f, 0.f, 0.f};
            const LAS unsigned char* vbase = F.lds + LDS_VS + (16 * qt + 4 * grp + (qi >> 2)) * KV_ROWB + (qi & 3) * 8;
#pragma unroll
            for (int kk = 0; kk < 5; ++kk) {
                u32x4 pw; pw.x = cvtpk(s[2 * kk][0], s[2 * kk][1]); pw.y = cvtpk(s[2 * kk][2], s[2 * kk][3]);
                if (kk < 4) { pw.z = cvtpk(s[2 * kk + 1 < 9 ? 2 * kk + 1 : 8][0], s[2 * kk + 1 < 9 ? 2 * kk + 1 : 8][1]); pw.w = cvtpk(s[2 * kk + 1 < 9 ? 2 * kk + 1 : 8][2], s[2 * kk + 1 < 9 ? 2 * kk + 1 : 8][3]); }
                else { pw.z = 0u; pw.w = 0u; }
                const bf16x8 pf = __builtin_bit_cast(bf16x8, pw);
                const int hi_rows = kk < 4 ? 16 : 0;
                bf16x8 vf[4];
#pragma unroll
                for (int d = 0; d < 4; ++d) {
                    const s16x4 lo = vtr(vbase + (32 * kk) * KV_ROWB + d * 32), hi = vtr(vbase + (32 * kk + hi_rows) * KV_ROWB + d * 32);
                    vf[d] = (bf16x8){lo[0], lo[1], lo[2], lo[3], hi[0], hi[1], hi[2], hi[3]}; }
#pragma unroll
                for (int d = 0; d < 4; ++d) o[d] = __builtin_amdgcn_mfma_f32_16x16x32_bf16(vf[d], pf, o[d], 0, 0, 0); }
            const float inv = 1.0f / sum;
            const size_t token = (size_t)b * SEQ + (size_t)tq * dil + res;
            bf16* op = OUTG + ((size_t)g * M + token) * AW + h * HD + 4 * grp;
#pragma unroll
            for (int d = 0; d < 4; ++d) { u32x2 w; w.x = cvtpk(o[d][0] * inv, o[d][1] * inv); w.y = cvtpk(o[d][2] * inv, o[d][3] * inv); *(u32x2*)(op + 16 * d) = w; }
            if (grp == 0) LSE[((size_t)g * M + token) * 8 + h] = (mx + __builtin_amdgcn_logf(sum)) * 0.6931471805599453f;
        }
    }
}

__device__ __forceinline__ void sample_attn_phase(const Ctx& F, int j, const float* RAW, float* OS) {
    LAS float* sq = (LAS float*)(F.lds);
    LAS float* sk = sq + 192;
    LAS float* sv = sk + 192;
    LAS float* slog = sv + 192;
    LAS float* sstat = slog + 396;
    LAS float* spart = sstat + 8;
    const int lane = F.lane;
    const float* biasw = (const float*)(F.ws + WS_BIAS);
    for (int it = F.G - 1 - F.bid; it < SB * NH; it += F.G) {
        const int b = it >> 3, h = it & 7;
        __syncthreads();
        for (int u = F.wave; u < 9; u += NWAVES) { const int g = u / 3, s = u % 3, d = lane;
            const int col = (g * 6 + s * 2 + (h >> 2)) * 256 + (d >> 5) * 128 + (h & 3) * 32 + (d & 31);
            float v = RAW[(size_t)b * QKVW + col];
            if (s < 2) { const float ss = wave_sum(v * v); const float r = 1.0f / sqrtf(ss * (1.0f / HD) + EPS); v = (v * r) * F.in[s == 0 ? 13 : 14][j * HD + d]; }
            (s == 0 ? sq : (s == 1 ? sk : sv))[g * 64 + d] = v;
            if (s >= 1) { const int keep = 128 << (2 * g); const size_t ob = g == 0 ? O_SK1 : (g == 1 ? O_SK4 : O_SK16);
                F.out[ob + ((((size_t)(j * SB + b) * keep + (keep - 1)) * 2 + (s - 1)) * NH + h) * HD + d] = v; } }
        __syncthreads();
        { f32x4 kv[13];
#pragma unroll
          for (int it2 = 0; it2 < 13; ++it2) { const int kidx = it2 * 32 + F.wave * 4 + (lane >> 4); const int kx = kidx < 387 ? kidx : 386, g = kx / 129, jj = kx % 129, keep = 128 << (2 * g), dil = 1 << (2 * g);
              const float* cache = F.in[3 + g];
              const int rowi = jj == 0 ? 0 : (keep - dil * jj);
              kv[it2] = *(const f32x4*)(cache + ((((size_t)(j * SB + b) * keep + rowi) * 2 + 0) * NH + h) * HD + 4 * (lane & 15)); }
#pragma unroll
          for (int it2 = 0; it2 < 13; ++it2) { const int kidx = it2 * 32 + F.wave * 4 + (lane >> 4); const bool act = kidx < 387; const int kx = act ? kidx : 386, g = kx / 129, jj = kx % 129;
              f32x4 kk = kv[it2]; if (jj == 0) kk = *(const LAS f32x4*)(sk + g * 64 + 4 * (lane & 15));
              const f32x4 qv = *(const LAS f32x4*)(sq + g * 64 + 4 * (lane & 15));
              float d = (kk[0] * qv[0] + kk[1] * qv[1]) + (kk[2] * qv[2] + kk[3] * qv[3]);
              d += sx<1>(d); d += sx<2>(d); d += sx<4>(d); d += sx<8>(d);
              if (act && (lane & 15) == 0) slog[g * 132 + jj] = d * 0.125f + biasw[(g * 8 + h) * 160 + 16 + jj]; } }
        __syncthreads();
        if (F.wave < 3) { const int g = F.wave;
            const float v0 = slog[g * 132 + lane], v1 = slog[g * 132 + 64 + lane], v2 = lane == 0 ? slog[g * 132 + 128] : -3.0e38f;
            const float m = wave_max(fmaxf(v0, fmaxf(v1, v2)));
            const float e0 = __expf(v0 - m), e1 = __expf(v1 - m), e2 = lane == 0 ? __expf(v2 - m) : 0.f;
            const float ssum = wave_sum(e0 + e1 + e2);
            slog[g * 132 + lane] = e0; slog[g * 132 + 64 + lane] = e1; if (lane == 0) { slog[g * 132 + 128] = e2; sstat[g * 2] = m + __logf(ssum); sstat[g * 2 + 1] = 1.0f / ssum; } }
        __syncthreads();
        { float a[3] = {0.f, 0.f, 0.f};
#pragma unroll
          for (int g = 0; g < 3; ++g) { const int keep = 128 << (2 * g), dil = 1 << (2 * g); const float* cache = F.in[3 + g];
              const float* vb = cache + ((((size_t)(j * SB + b) * keep) * 2 + 1) * NH + h) * HD + lane;
              float vv[17];
#pragma unroll
              for (int q = 0; q < 17; ++q) { const int jj = F.wave + 8 * q; const int rowi = (jj == 0 || jj > 128) ? 0 : (keep - dil * jj); vv[q] = vb[(size_t)rowi * 2 * NH * HD]; }
#pragma unroll
              for (int q = 0; q < 17; ++q) { const int jj = F.wave + 8 * q; if (jj <= 128) { const float v = jj == 0 ? sv[g * 64 + lane] : vv[q]; a[g] += slog[g * 132 + jj] * v; } } }
#pragma unroll
          for (int g = 0; g < 3; ++g) spart[(F.wave * 3 + g) * 64 + lane] = a[g]; }
        __syncthreads();
        if (F.tid < 64) { const int d = F.tid;
            const float l0 = sstat[0], l1 = sstat[2], l2 = sstat[4], mx = fmaxf(l0, fmaxf(l1, l2));
            const float w0 = __expf(l0 - mx), w1 = __expf(l1 - mx), w2 = __expf(l2 - mx), inv = 1.0f / (w0 + w1 + w2);
            float o0 = 0.f, o1 = 0.f, o2 = 0.f;
#pragma unroll
            for (int w = 0; w < 8; ++w) { o0 += spart[(w * 3 + 0) * 64 + d]; o1 += spart[(w * 3 + 1) * 64 + d]; o2 += spart[(w * 3 + 2) * 64 + d]; }
            OS[(size_t)b * AW + h * HD + d] = (w0 * o0 * sstat[1] + w1 * o1 * sstat[3] + w2 * o2 * sstat[5]) * inv; }
    }
    __syncthreads();
}

__device__ __forceinline__ bf16x8 pack_frag(const float (&x)[8]) { u32x4 w; w.x = cvtpk(x[0], x[1]); w.y = cvtpk(x[2], x[3]); w.z = cvtpk(x[4], x[5]); w.w = cvtpk(x[6], x[7]); return __builtin_bit_cast(bf16x8, w); }
__device__ __forceinline__ int tile_row(int tile, int c, int NP) { return tile < NP ? 256 * (tile >> 3) + 16 * (tile & 7) + (c & 15) + 128 * (c >> 4) : tile * 32 + c; }
template <class LA, class EP> __device__ __forceinline__ void skinny_gemm(const Ctx& F, const LA& la, const EP& ep, const bf16* Wt, int N, int K, int NP, int first, int nworkers) {
    const int ntiles = N >> 5;
    if (first < 0 || first >= nworkers || first >= ntiles) return;
    LAS float* red = (LAS float*)F.lds;
    const int lane = F.lane, col = lane & 31, half = lane >> 5, kslice = K >> 3, kbeg = F.wave * kslice;
    for (int tile = first; tile < ntiles; tile += nworkers) {
        f32x16 acc;
#pragma unroll
        for (int r = 0; r < 16; ++r) acc[r] = 0.f;
        const bf16* wrow = Wt + (size_t)tile_row(tile, col, NP) * K + kbeg + 16 * half;
#pragma unroll 4
        for (int kb = 0; kb < kslice; kb += 32) {
            const bf16x8 b0 = *(const bf16x8*)(wrow + kb), b1 = *(const bf16x8*)(wrow + kb + 8);
            const bf16x8 a0 = la.frag(col, kbeg + kb + 16 * half), a1 = la.frag(col, kbeg + kb + 16 * half + 8);
            acc = __builtin_amdgcn_mfma_f32_32x32x16_bf16(a0, b0, acc, 0, 0, 0);
            acc = __builtin_amdgcn_mfma_f32_32x32x16_bf16(a1, b1, acc, 0, 0, 0); }
        __syncthreads();
#pragma unroll
        for (int r = 0; r < 16; ++r) { const int row = (r & 3) + 8 * (r >> 2) + 4 * half; red[(F.wave * 32 + row) * 33 + col] = acc[r]; }
        __syncthreads();
        { const int row = F.tid >> 4, c0 = F.tid & 15; float v0 = 0.f, v1 = 0.f;
#pragma unroll
          for (int w = 0; w < 8; ++w) { v0 += red[(w * 32 + row) * 33 + c0]; v1 += red[(w * 32 + row) * 33 + c0 + 16]; }
          ep(tile, row, c0, v0, v1); }
    }
    __syncthreads();
}
struct LoadBf16 { const bf16* A; int K;
    __device__ __forceinline__ bf16x8 frag(int row, int k) const { return *(const bf16x8*)(A + (size_t)row * K + k); } };
struct LoadMulF32 { const float* P; const float* Q; int K;
    __device__ __forceinline__ bf16x8 frag(int row, int k) const { const f32x4 p0 = *(const f32x4*)(P + (size_t)row * K + k), p1 = *(const f32x4*)(P + (size_t)row * K + k + 4), q0 = *(const f32x4*)(Q + (size_t)row * K + k), q1 = *(const f32x4*)(Q + (size_t)row * K + k + 4);
        float x[8];
#pragma unroll
        for (int q = 0; q < 4; ++q) { x[q] = p0[q] * q0[q]; x[4 + q] = p1[q] * q1[q]; }
        return pack_frag(x); } };
struct LoadF32 { const float* P; int K;
    __device__ __forceinline__ bf16x8 frag(int row, int k) const { const f32x4 p0 = *(const f32x4*)(P + (size_t)row * K + k), p1 = *(const f32x4*)(P + (size_t)row * K + k + 4);
        float x[8];
#pragma unroll
        for (int q = 0; q < 4; ++q) { x[q] = p0[q]; x[4 + q] = p1[q]; }
        return pack_frag(x); } };
__device__ __forceinline__ bf16 f2bf1(float x) { return (bf16)(cvtpk(x, 0.f) & 0xffffu); }
struct EpiSIn { const u64* ss; const float* hist; const float* cw; float* ZC; float* BGs; float* hout;
    __device__ __forceinline__ void operator()(int tile, int row, int c0, float v0, float v1) const {
        const float r = rs_of(ss + row);
        if (tile < 64) { const int ch = 128 * (tile >> 3) + 16 * (tile & 7) + c0; const float z = (r * v0) * (r * v1);
            const float h0 = hist[((size_t)row * 2 + 0) * DM + ch], h1 = hist[((size_t)row * 2 + 1) * DM + ch];
            ZC[(size_t)row * DM + ch] = cw[ch] * h0 + cw[DM + ch] * h1 + cw[2 * DM + ch] * z;
            hout[((size_t)row * 2 + 0) * DM + ch] = h1; hout[((size_t)row * 2 + 1) * DM + ch] = z; }
        else { const int ch = (tile - 64) * 32 + c0; BGs[(size_t)row * DM + ch] = r * v0; BGs[(size_t)row * DM + ch + 16] = r * v1; } } };
struct EpiSRes { const float* xs_in; float* xs_out; const float* gamma_next; bf16* as_next; u64* ss_next; float* yout;
    __device__ __forceinline__ void operator()(int tile, int row, int c0, float v0, float v1) const {
        const int col = tile * 32 + c0; const float x0 = xs_in[(size_t)row * DM + col] + v0, x1 = xs_in[(size_t)row * DM + col + 16] + v1;
        if (xs_out) { xs_out[(size_t)row * DM + col] = x0; xs_out[(size_t)row * DM + col + 16] = x1; }
        if (yout) { yout[(size_t)row * DM + col] = x0; yout[(size_t)row * DM + col + 16] = x1; }
        if (as_next) { as_next[(size_t)row * DM + col] = f2bf1(x0); as_next[(size_t)row * DM + col + 16] = f2bf1(x1);
            float p = x0 * x0 + x1 * x1; p += sx<1>(p); p += sx<2>(p); p += sx<4>(p); p += sx<8>(p);
            if (c0 == 0) atomicAdd(ss_next + row, ss_fix(p)); } } };
struct EpiSGU { const u64* ss; const float* hist; const float* cw; const float* cb; bf16* ADN; float* hout;
    __device__ __forceinline__ void operator()(int tile, int row, int c0, float v0, float v1) const {
        const float r = rs_of(ss + row);
        const int ch = 128 * (tile >> 3) + 16 * (tile & 7) + c0; const float G = r * v0, U = r * v1;
        const float h0 = hist[((size_t)row * 2 + 0) * DFF + ch], h1 = hist[((size_t)row * 2 + 1) * DFF + ch];
        const float pre = cw[ch] * h0 + cw[DFF + ch] * h1 + cw[2 * DFF + ch] * G + cb[ch];
        ADN[(size_t)row * DFF + ch] = f2bf1(silu_f(pre) * U);
        hout[((size_t)row * 2 + 0) * DFF + ch] = h1; hout[((size_t)row * 2 + 1) * DFF + ch] = G; } };
struct EpiSQKV { const u64* ss; float* RAW;
    __device__ __forceinline__ void operator()(int tile, int row, int c0, float v0, float v1) const {
        const float r = rs_of(ss + row);
        RAW[(size_t)row * QKVW + tile * 32 + c0] = r * v0; RAW[(size_t)row * QKVW + tile * 32 + c0 + 16] = r * v1; } };


#define XB_TMO      128
#define XB_XCNT(j)  (256  + 64 * (j))
#define XB_XSUB(j)  (1280 + 64 * (j))
#define XB_XGEN(j)  (2304 + 64 * (j))
#define XB_TOP      3328
#define XB_TOPGEN   3392
#define XCD_BAR_WORDS 3456
#define XB_SPIN_CAP (1u << 18)

__device__ __forceinline__ unsigned xb_ld(unsigned* p)              { return __hip_atomic_load(p, __ATOMIC_RELAXED, __HIP_MEMORY_SCOPE_AGENT); }
__device__ __forceinline__ unsigned xb_add(unsigned* p, unsigned v) { return __hip_atomic_fetch_add(p, v, __ATOMIC_RELAXED, __HIP_MEMORY_SCOPE_AGENT); }
__device__ __forceinline__ unsigned xb_xcc_id() { return (unsigned)__builtin_amdgcn_s_getreg((3 << 11) | 20) & 0xFu; }
#define XB_SPIN(cond, bar) do { unsigned _sp = 0; while (cond) { __builtin_amdgcn_s_sleep(1); \
    if ((++_sp & 255u) == 0u) { if (xb_ld(&(bar)[XB_TMO])) break; if (_sp > XB_SPIN_CAP) { atomicAdd(&(bar)[XB_TMO], 1u); break; } } } } while (0)

struct XcdBarrier {
    unsigned* bar; unsigned x;
    volatile LAS unsigned* st;
};

__device__ __forceinline__ XcdBarrier xcd_barrier_post(unsigned* bar, volatile LAS unsigned* st) {
    XcdBarrier b; b.bar = bar; b.x = xb_xcc_id(); b.st = st;
    if (threadIdx.x == 0) (void)xb_add(&bar[XB_XCNT(b.x)], 1u);
    return b;
}
__device__ __forceinline__ void xcd_barrier_complete(unsigned* bar, unsigned x, unsigned& nloc, unsigned& nx) {
    const unsigned G = gridDim.x * gridDim.y * gridDim.z;
    unsigned sum, cnt, mine, sp = 0u;
    for (;;) {
        sum = 0u; cnt = 0u; mine = 0u;
#pragma unroll
        for (unsigned j = 0; j < 16; ++j) { const unsigned c = xb_ld(&bar[XB_XCNT(j)]); sum += c; cnt += (c > 0u) ? 1u : 0u; mine = (j == x) ? c : mine; }
        if (sum == G) break;
        __builtin_amdgcn_s_sleep(1);
        if ((++sp & 255u) == 0u) { if (xb_ld(&bar[XB_TMO])) break; if (sp > XB_SPIN_CAP) { atomicAdd(&bar[XB_TMO], 1u); break; } }
    }
    nloc = mine > 0u ? mine : 1u; nx = cnt > 0u ? cnt : 1u;
}

__device__ __forceinline__ void xcd_barrier(const XcdBarrier& b) {
    asm volatile("s_waitcnt vmcnt(0)" ::: "memory");
    __syncthreads();
    if (threadIdx.x == 0) {
        unsigned* bar = b.bar;
        __builtin_amdgcn_s_waitcnt(0);
        unsigned nloc = b.st[0], nx = b.st[1];
        if (nloc == 0u) { xcd_barrier_complete(bar, b.x, nloc, nx); b.st[0] = nloc; b.st[1] = nx; }
        const unsigned old = xb_add(&bar[XB_XSUB(b.x)], 1u);
        const unsigned gen = old / nloc;
        if (old + 1u == (gen + 1u) * nloc) {
            __builtin_amdgcn_fence(__ATOMIC_RELEASE, "agent");
            asm volatile("s_waitcnt vmcnt(0)" ::: "memory");
            const unsigned og = xb_add(&bar[XB_TOP], 1u);
            const unsigned tg = og / nx;
            if (og + 1u == (tg + 1u) * nx) xb_add(&bar[XB_TOPGEN], 1u);
            else XB_SPIN(xb_ld(&bar[XB_TOPGEN]) == tg, bar);
            __builtin_amdgcn_fence(__ATOMIC_ACQUIRE, "agent");
            xb_add(&bar[XB_XGEN(b.x)], 1u);
            asm volatile("s_waitcnt vmcnt(0)" ::: "memory");
        } else {
            XB_SPIN(xb_ld(&bar[XB_XGEN(b.x)]) == gen, bar);
            __builtin_amdgcn_fence(__ATOMIC_ACQUIRE, "agent");
            asm volatile("s_waitcnt vmcnt(0)" ::: "memory");
        }
    }
    __syncthreads();
}


#ifndef PG8_SP2
#define PG8_SP2 true
#endif
struct Args { const float* in[22]; float* out; unsigned char* ws; int ph_lo, ph_hi; };
enum { I_XP = 0, I_XS, I_STSC, I_C1, I_C4, I_C16, I_STFFN, I_NMIX, I_NFFN, I_WIN, I_SCCW, I_WOUT, I_WQKV, I_QN, I_KN, I_WAO, I_RELB, I_WGATE, I_WUP, I_FCW, I_FCB, I_WDN };
__device__ __forceinline__ Ctx fresh(const Ctx& F0) {
    Ctx P = F0; int t; asm volatile("v_mbcnt_lo_u32_b32 %0, -1, 0\n\tv_mbcnt_hi_u32_b32 %0, -1, %0" : "=v"(t)); t += F0.wave * 64; P.tid = t; P.lane = t & 63; P.wave = __builtin_amdgcn_readfirstlane(t >> 6);
    long z = 0; int bb = F0.bid; asm volatile("" : "+s"(z), "+s"(bb)); P.bid = bb;
    P.ws = F0.ws + z; P.out = F0.out + z; P.in = F0.in + z; return P;
}
#define HN ((bf16*)(ws + WS_HN))
#define ZB ((bf16*)(ws + WS_ZB))
#define BGB ((bf16*)(ws + WS_BGB))
#define UB ((bf16*)(ws + WS_UB))
#define GB ((bf16*)(ws + WS_GB))
#define UPB ((bf16*)(ws + WS_UPB))
#define ACT ((bf16*)(ws + WS_ACT))
#define QP ((bf16*)(ws + WS_QP))
#define KP ((bf16*)(ws + WS_KP))
#define VP ((bf16*)(ws + WS_VP))
#define OUTG ((bf16*)(ws + WS_OUTG))
#define LSE ((float*)(ws + WS_LSE))
#define OB ((bf16*)(ws + WS_OB))
#define XSA ((float*)(ws + WS_XSA))
#define XSB ((float*)(ws + WS_XSB))
#define RAWA ((float*)(ws + WS_RAWA))
#define RAWO ((float*)(ws + WS_RAWO))
#define RAWGU ((float*)(ws + WS_RAWGU))
#define RAWDN ((float*)(ws + WS_RAWDN))
#define OS ((float*)(ws + WS_OS))
#define ASM ((bf16*)(ws + WS_ASM))
#define ASG ((bf16*)(ws + WS_ASG))
#define ADN ((bf16*)(ws + WS_ADN))
#define ZC ((float*)(ws + WS_ZC))
#define BGS ((float*)(ws + WS_BGS))
#define SSP(n) ((u64*)(ws + WS_SSP) + (size_t)(n) * M)
#define SSS(n) ((u64*)(ws + WS_SSS) + (n) * SB)
#define XS_IN(s) ((s) == 0 ? F.in[I_XS] : (((s) & 1) ? (const float*)XSA : (const float*)XSB))
#define XS_OUT(s) (((s) & 1) ? XSB : XSA)
#define XRES (F.out + O_YP)
__global__ void __launch_bounds__(NTHR, 2) mega_fwd(Args args) {
    extern __shared__ __attribute__((aligned(16))) unsigned char lds_raw[];
    cg::grid_group grid = cg::this_grid();
    Ctx F0;
    F0.lds = (LAS unsigned char*)lds_raw; F0.tid = threadIdx.x; F0.lane = F0.tid & 63; F0.wave = __builtin_amdgcn_readfirstlane(F0.tid >> 6); F0.G = gridDim.x; F0.bid = blockIdx.x;
    F0.in = args.in; F0.out = args.out; F0.ws = args.ws;
    constexpr int NPHASES = 23;
    const int lo = args.ph_lo, hi = args.ph_hi < NPHASES ? args.ph_hi : NPHASES; int ph = 0;
    if (F0.tid < 64) ((LAS unsigned*)(F0.lds + LDS_CTL_OFF))[F0.tid] = 0u;
    __syncthreads();
    const XcdBarrier xbar = xcd_barrier_post((unsigned*)args.ws, (volatile LAS unsigned*)(F0.lds + LDS_CTL_OFF));
#define PH_ON() (ph >= lo && ph < hi)
#define PH_CTX() const Ctx F = fresh(F0); unsigned char* ws = F.ws; (void)ws
#define PH_END() do { if (ph >= lo && ph + 1 < hi) { if (lo < 0) grid.sync(); else xcd_barrier(xbar); } ++ph; } while (0)

    if (PH_ON()) { PH_CTX(); prologue_phase(F); }
    PH_END();

#pragma unroll 1
    for (int i = 0; i < DEPTH; ++i) {
        const int j = i >> 1;
        if ((i & 1) == 0) {
            if (PH_ON()) { PH_CTX();
                { LoadBf16 la{ASM, 1024}; EpiSIn ep{SSS(2 * i), F.in[I_STSC] + (size_t)j * SB * 2 * DM, F.in[I_SCCW] + (size_t)j * 3 * DM, ZC, BGS, F.out + O_SSC + (size_t)j * SB * 2 * DM};
                  skinny_gemm(F, la, ep, (const bf16*)(ws + WS_WIN) + (size_t)j * 3072 * 1024, 3072, 1024, 64, F.G - 1 - F.bid, F.G); }
                pg8::Gemm g{HN, (const bf16*)(ws + WS_WIN) + (size_t)j * 3072 * 1024, M, 3072, 1024}; pg8::StaticOrder S; S.init(M, 3072, F.G, F.bid);
                preload_rtab(F, S, SSP(2 * i));
                EpiIn E{ZB, BGB, F.out + O_PSC + (size_t)j * NBATCH * 2 * DM, (const LAS float*)(F.lds + LDS_RTAB_OFF)};
                pg8::gemm_phase<EpiIn, pg8::StaticOrder, true, PG8_SP2>(F.lds, g, S, E, F.tid);
            }
            PH_END();
            if (PH_ON()) { PH_CTX();
                { LoadMulF32 la{BGS, ZC, 1024}; EpiSRes ep{XS_IN(2 * i), XS_OUT(2 * i), F.in[I_NFFN] + (size_t)i * DM, ASG, SSS(2 * i + 1), nullptr};
                  skinny_gemm(F, la, ep, (const bf16*)(ws + WS_WOUT) + (size_t)j * 1024 * 1024, 1024, 1024, 0, F.bid, 32); }
                conv_ew_phase(F, ZB, BGB, F.in[I_SCCW] + (size_t)j * 3 * DM, UB, F.bid - 32, F.G - 32);
            }
            PH_END();
        } else {
            if (PH_ON()) { PH_CTX();
                const int GQ = F.G == 256 ? 232 : ((F.G - 24) & ~7);
                { LoadBf16 la{ASM, 1024}; EpiSQKV ep{SSS(2 * i), RAWA};
                  skinny_gemm(F, la, ep, (const bf16*)(ws + WS_WQKV) + (size_t)j * QKVW * 1024, QKVW, 1024, 0, F.bid - (GQ - 8), F.G - (GQ - 8)); }
                pg8::Gemm g{HN, (const bf16*)(ws + WS_WQKV) + (size_t)j * QKVW * 1024, M, QKVW, 1024}; pg8::StaticOrder S; S.init(M, QKVW, GQ, F.bid);
                const float* qnp = F.in[I_QN] + (size_t)j * HD; const float* knp = F.in[I_KN] + (size_t)j * HD;
                EpiQKV E{QP, qnp, (long)(knp - qnp), F.out, j, (const LAS float*)(F.lds + LDS_RTAB_OFF)};
                if (F.bid < GQ) { preload_rtab(F, S, SSP(2 * i)); pg8::gemm_phase<EpiQKV, pg8::StaticOrder, true, PG8_SP2>(F.lds, g, S, E, F.tid); gemm_done(F, i); }
                copy_while(F, i, (unsigned)GQ);
            }
            PH_END();
            if (PH_ON()) { PH_CTX(); attn_phase(F, QP, KP, VP, OUTG, LSE); sample_attn_phase(F, j, RAWA, OS); }
            PH_END();
            if (PH_ON()) { PH_CTX();
                { LoadF32 la{OS, AW}; EpiSRes ep{XS_IN(2 * i), XS_OUT(2 * i), F.in[I_NFFN] + (size_t)i * DM, ASG, SSS(2 * i + 1), nullptr};
                  skinny_gemm(F, la, ep, (const bf16*)(ws + WS_WAO) + (size_t)j * 1024 * 512, 1024, 512, 0, F.bid, 32); }
                merge_phase(F, OUTG, LSE, OB, F.bid - 32, F.G - 32);
            }
            PH_END();
        }
        if (PH_ON()) { PH_CTX();
            pg8::Gemm g; g.M = M; g.N = 1024;
            if ((i & 1) == 0) { g.A = UB; g.Bt = (const bf16*)(ws + WS_WOUT) + (size_t)j * 1024 * 1024; g.K = 1024; }
            else { g.A = OB; g.Bt = (const bf16*)(ws + WS_WAO) + (size_t)j * 1024 * 512; g.K = 512; }
            pg8::StaticOrder S; S.init(M, 1024, F.G, F.bid);
            EpiRes E{i == 0 ? F.in[I_XP] : nullptr, HN, SSP(2 * i + 1), nullptr};
            pg8::gemm_phase<EpiRes, pg8::StaticOrder, false, PG8_SP2>(F.lds, g, S, E, F.tid);
        }
        PH_END();
        if (PH_ON()) { PH_CTX();
            const int GU = F.G == 256 ? 240 : ((F.G - 16) & ~7);
            { LoadBf16 la{ASG, 1024}; EpiSGU ep{SSS(2 * i + 1), F.in[I_STFFN] + (size_t)i * SB * 2 * DFF, F.in[I_FCW] + (size_t)i * 3 * DFF, F.in[I_FCB] + (size_t)i * DFF, ADN, F.out + O_SFFN + (size_t)i * SB * 2 * DFF};
              skinny_gemm(F, la, ep, (const bf16*)(ws + WS_WGU) + (size_t)i * 5632 * 1024, 5632, 1024, 176, F.bid - (GU - 32), F.G - (GU - 32));
              const int wk = F.bid - (GU - 32), nwk = F.G - (GU - 32);
              if (wk >= 0 && wk < 176 && F.tid == 0) { __threadfence(); __hip_atomic_fetch_add((unsigned*)ws + CW_SGU + 64 * i, (unsigned)((176 - wk + nwk - 1) / nwk), __ATOMIC_RELAXED, __HIP_MEMORY_SCOPE_AGENT); } }
            if (F.bid >= GU) {
                if (F.tid == 0) { unsigned sp = 0; while (__hip_atomic_load((unsigned*)ws + CW_SGU + 64 * i, __ATOMIC_RELAXED, __HIP_MEMORY_SCOPE_AGENT) < 176u && ++sp < (1u << 22)) __builtin_amdgcn_s_sleep(2); __threadfence(); }
                __syncthreads();
                const bool lastl = (i == DEPTH - 1); LoadBf16 la{ADN, DFF};
                EpiSRes ep{XS_IN(2 * i + 1), lastl ? nullptr : XS_OUT(2 * i + 1), F.in[I_NMIX] + (size_t)(lastl ? i : i + 1) * DM, lastl ? nullptr : ASM, SSS(lastl ? 7 : 2 * i + 2), lastl ? F.out + O_YS : nullptr};
                skinny_gemm(F, la, ep, (const bf16*)(ws + WS_WDN) + (size_t)i * 1024 * 2816, 1024, 2816, 0, F.bid - GU, F.G - GU); }
            pg8::Gemm g{HN, (const bf16*)(ws + WS_WGU) + (size_t)i * 5632 * 1024, M, 5632, 1024}; pg8::StaticOrder S; S.init(M, 5632, GU, F.bid);
            EpiGUF E{ACT, F.out + O_PFFN + (size_t)i * NBATCH * 2 * DFF, (const LAS float*)(F.lds + LDS_RTAB_OFF), F.in[I_FCW] + (size_t)i * 3 * DFF, F.in[I_FCB] + (size_t)i * DFF, (float*)(ws + WS_GH), (float*)(ws + WS_PRE), (float*)(ws + WS_UH), (LAS float*)(F.lds + LDS_HALO_OFF)};
            if (F.bid < GU) { preload_rtab(F, S, SSP(2 * i + 1)); pg8::gemm_phase<EpiGUF, pg8::StaticOrder, true, PG8_SP2>(F.lds, g, S, E, F.tid); gemm_done(F, 4 + i); }
            copy_while(F, 4 + i, (unsigned)GU);
        }
        PH_END();
        if (PH_ON()) { PH_CTX();
            pg8::Gemm g{ACT, (const bf16*)(ws + WS_WDN) + (size_t)i * 1024 * 2816, M, 1024, 2816}; pg8::StaticOrder S; S.init(M, 1024, F.G, F.bid);
            { pg8::Unit u0; if (S.next(0, u0)) ffn_fixup_panel(F, u0.pm, (const float*)(ws + WS_GH), (const float*)(ws + WS_PRE), (const float*)(ws + WS_UH), F.in[I_FCW] + (size_t)i * 3 * DFF, ACT); }
            const bool lastp = (i == DEPTH - 1);
            EpiRes E{nullptr, HN, SSP(lastp ? 7 : 2 * i + 2), lastp ? F.out + O_YP : nullptr};
            pg8::gemm_phase<EpiRes, pg8::StaticOrder, false, PG8_SP2>(F.lds, g, S, E, F.tid);
        }
        PH_END();
    }
    { const Ctx F = fresh(F0); copy_while(F, 0, ~0u); }
}

extern "C" void kernel_launch(void* const* d_in, const int* in_sizes, int n_in, void* d_out, int out_size, void* d_ws, size_t ws_size, hipStream_t stream) {
    static int grid = 0;
    if (grid == 0) {
        if (n_in != 22 || (size_t)out_size != O_END || ws_size < WS_END) { fprintf(stderr, "kernel_launch: unexpected problem geometry (n_in %d, out %d, ws %zu; need 22, %zu, >= %zu)\n", n_in, out_size, ws_size, (size_t)O_END, (size_t)WS_END); grid = -1; return; }
        int dev = 0, cus = 0, per_cu = 0;
        if (hipGetDevice(&dev) != hipSuccess || hipDeviceGetAttribute(&cus, hipDeviceAttributeMultiprocessorCount, dev) != hipSuccess) { fprintf(stderr, "kernel_launch: device query failed\n"); grid = -1; return; }
        if (hipFuncSetAttribute((const void*)mega_fwd, hipFuncAttributeMaxDynamicSharedMemorySize, LDS_BYTES) != hipSuccess) { fprintf(stderr, "kernel_launch: hipFuncSetAttribute failed\n"); grid = -1; return; }
        if (hipOccupancyMaxActiveBlocksPerMultiprocessor(&per_cu, (const void*)mega_fwd, NTHR, LDS_BYTES) != hipSuccess || per_cu < 1) { fprintf(stderr, "kernel_launch: occupancy query gave %d\n", per_cu); per_cu = 1; }
        (void)hipGetLastError();
        grid = cus * (per_cu > 1 ? 1 : per_cu);
    }
    if (grid < 0) return;
    if (hipMemsetAsync(d_ws, 0, 32768, stream) != hipSuccess) { fprintf(stderr, "kernel_launch: memset of the barrier words failed\n"); return; }
    Args a{};
    for (int i = 0; i < 22; ++i) a.in[i] = (const float*)d_in[i];
    a.out = (float*)d_out; a.ws = (unsigned char*)d_ws; a.ph_lo = 0; a.ph_hi = 1000;
#if defined(MK_PER_PHASE)
    for (int p = 0; p < 64; ++p) { a.ph_lo = p; a.ph_hi = p + 1; hipLaunchKernelGGL(mega_fwd, dim3(grid), dim3(NTHR), LDS_BYTES, stream, a); }
#else
    void* params[] = {&a};
    hipError_t e = hipLaunchCooperativeKernel((const void*)mega_fwd, dim3(grid), dim3(NTHR), params, LDS_BYTES, stream);
    if (e != hipSuccess) fprintf(stderr, "kernel_launch: cooperative launch failed: %s (grid %d)\n", hipGetErrorString(e), grid);
#endif
}
```

```cpp
#include <hip/hip_runtime.h>
#include <hip/hip_cooperative_groups.h>
#include <cstdio>
#include <cstdint>
#include <cmath>
namespace cg = cooperative_groups;
#pragma clang fp contract(fast)
namespace pg8 {
#define PG8_LAS __attribute__((address_space(3)))
typedef unsigned short bf16_t;
typedef short bf16x8 __attribute__((ext_vector_type(8)));
typedef float f32x4 __attribute__((ext_vector_type(4)));
typedef unsigned u32x4 __attribute__((ext_vector_type(4)));
constexpr int BM = 256, BK = 64, HALF = 128, HTB = HALF * BK * 2  , STAGE_BYTES = 8 * HTB, NXCD = 8, WGM = 8;

__host__ __device__ __forceinline__ int lds_byte(int r, int c) { const int st = (r >> 4) * 2 + (c >> 5), rr = r & 15, cc = c & 31, ob = rr * 64 + cc * 2; return st * 1024 + (ob ^ (((ob >> 9) & 1) << 5)); }
__host__ __device__ __forceinline__ void stage_rc(int b, int& R, int& C) { const int st = b / 1024, sb = b % 1024, swz = sb ^ (((sb >> 9) & 1) << 5); R = (st >> 1) * 16 + swz / 64; C = (st & 1) * 32 + (swz % 64) / 2; }
__host__ __device__ __forceinline__ int perm32(int rho) { const int n = rho >> 4, i = rho & 15; return 8 * (i >> 2) + 4 * n + (i & 3); }

struct Unit { int pm, pn; };
struct Gemm { const bf16_t* A; const bf16_t* Bt; int M, N, K; };

struct StaticOrder {
    int nM, nN, nwg, G, c, wgm;
    __host__ __device__ __forceinline__ void init(int M, int N, int G_, int c_, int wgm_ = WGM) { nM = M / BM; nN = N / BM; nwg = nM * nN; G = G_; c = c_; wgm = wgm_; }
    __host__ __device__ __forceinline__ bool next(int i, Unit& u) const {
        const long L = (long)i * G + c; if (L >= nwg) return false;
        int wgid = (int)L; { const int q = nwg / NXCD, r = nwg % NXCD, xcd = wgid % NXCD, off = wgid / NXCD; wgid = (xcd < r ? xcd * (q + 1) : r * (q + 1) + (xcd - r) * q) + off; }
        const int nig = wgm * nN, gid = wgid / nig, fm = gid * wgm, gsz = (nM - fm) < wgm ? (nM - fm) : wgm;
        u.pm = fm + ((wgid % nig) % gsz); u.pn = (wgid % nig) / gsz; return true;
    }
    __device__ __forceinline__ void a_ready(const Unit&) const {}
    __device__ __forceinline__ void done(const Unit&) const {}
};

typedef float cvt_f32x2 __attribute__((ext_vector_type(2))); typedef __bf16 cvt_bf16x2 __attribute__((ext_vector_type(2)));
__device__ __forceinline__ unsigned cvt_pk_bf16(float lo, float hi) { const cvt_f32x2 v = {lo, hi}; return __builtin_bit_cast(unsigned, __builtin_convertvector(v, cvt_bf16x2)); }

template <class Epi, class Sched, bool ALIGN_EPI = false, bool SP2 = false>
__device__ __forceinline__ void gemm_phase(PG8_LAS unsigned char* lds, const Gemm g, const Sched& S, const Epi& E, int tid_in) {
    int tid_ = tid_in; asm volatile("" : "+v"(tid_));
    const int tid = tid_, wid = __builtin_amdgcn_readfirstlane(tid >> 6), lane = tid & 63, wr = wid >> 2, wc = wid & 3, fr = lane & 15, fq = lane >> 4;
    const int K = g.K, nt = K / BK;
    unsigned voffA[2], voffB[2];
#pragma unroll
    for (int i = 0; i < 2; ++i) { int R, C; stage_rc(tid * 16 + i * 8192, R, C); const int Rb = Epi::PERM ? ((R & ~31) + perm32(R & 31)) : R;
        const int Ra = Epi::APERM ? (64 * (R >> 6) + 4 * (R & 15) + ((R >> 4) & 3)) : R;
        voffA[i] = (unsigned)(Ra * K + C) * 2u; voffB[i] = (unsigned)(Rb * K + C) * 2u; }
    const size_t kstep = (size_t)(BK * 2);
    const size_t hstep = (size_t)HALF * K * 2;
    const size_t tstep = 2 * hstep;
    const unsigned ldsw = (unsigned)wid * 1024u;
    const int aoff = lds_byte(wr * 64 + fr, fq * 8), boff = lds_byte(wc * 32 + fr, fq * 8);
#define PG8_SA(b, h) (((b) * 2 + (h)) * HTB)
#define PG8_SB(b, h) ((4 + (b) * 2 + (h)) * HTB)
#define PG8_STAGE(bufoff, gbase, voff) do { _Pragma("unroll") for (int _i = 0; _i < 2; ++_i) \
        __builtin_amdgcn_global_load_lds((const unsigned*)((const char*)(gbase) + (voff)[_i]), (PG8_LAS unsigned*)(lds + (bufoff) + ldsw + _i * 8192), 16, 0, 0); } while (0)
#define PG8_LDA(dst, b, h) do { _Pragma("unroll") for (int m = 0; m < 4; ++m) _Pragma("unroll") for (int k = 0; k < 2; ++k) dst[m][k] = *(const PG8_LAS bf16x8*)(lds + PG8_SA(b, h) + aoff + m * 2048 + k * 1024); } while (0)
#define PG8_LDB(dst, b, h) do { _Pragma("unroll") for (int n = 0; n < 2; ++n) _Pragma("unroll") for (int k = 0; k < 2; ++k) dst[n][k] = *(const PG8_LAS bf16x8*)(lds + PG8_SB(b, h) + boff + n * 2048 + k * 1024); } while (0)
#define PG8_MMA(ai, bj, At, Bt) do { __builtin_amdgcn_s_setprio(1); _Pragma("unroll") for (int m = 0; m < 4; ++m) _Pragma("unroll") for (int n = 0; n < 2; ++n) _Pragma("unroll") for (int k = 0; k < 2; ++k) \
        acc[ai][bj][m][n] = __builtin_amdgcn_mfma_f32_16x16x32_bf16(Bt[n][k], At[m][k], acc[ai][bj][m][n], 0, 0, 0); __builtin_amdgcn_s_setprio(0); } while (0)
#define PG8_WAIT_V(n) asm volatile("s_waitcnt vmcnt(" #n ")" ::: "memory")
#define PG8_WAIT_L(n) asm volatile("s_waitcnt lgkmcnt(" #n ")" ::: "memory")
#define PG8_BAR __builtin_amdgcn_s_barrier()
#define PG8_SCHED __builtin_amdgcn_sched_barrier(0)
    Unit cur, nxt; int ui = 0;
    if (!S.next(0, cur)) return;
    f32x4 acc[2][2][4][2];
#pragma unroll
    for (int a = 0; a < 2; ++a)
#pragma unroll
        for (int b = 0; b < 2; ++b)
#pragma unroll
            for (int m = 0; m < 4; ++m)
#pragma unroll
                for (int n = 0; n < 2; ++n) acc[a][b][m][n] = (f32x4){0.f, 0.f, 0.f, 0.f};
    bf16x8 At[4][2], B0[2][2], B1[2][2];
    const char* cA = (const char*)g.A + (size_t)cur.pm * tstep; const char* cB = (const char*)g.Bt + (size_t)cur.pn * tstep;
    S.a_ready(cur);
    if constexpr (SP2) {
        PG8_STAGE(PG8_SB(0, 0), cB, voffB); PG8_STAGE(PG8_SB(0, 1), cB + hstep, voffB); PG8_STAGE(PG8_SA(0, 0), cA, voffA); PG8_STAGE(PG8_SA(0, 1), cA + hstep, voffA);
        if (wr == 1) PG8_BAR;
        PG8_WAIT_V(2); PG8_BAR;
        PG8_STAGE(PG8_SB(1, 0), cB + kstep, voffB); PG8_STAGE(PG8_SA(1, 0), cA + kstep, voffA); PG8_STAGE(PG8_SB(1, 1), cB + hstep + kstep, voffB);
        PG8_WAIT_V(6); PG8_BAR;
    } else {
        PG8_STAGE(PG8_SB(0, 0), cB, voffB); PG8_STAGE(PG8_SA(0, 0), cA, voffA); PG8_STAGE(PG8_SB(0, 1), cB + hstep, voffB); PG8_STAGE(PG8_SA(0, 1), cA + hstep, voffA);
        if (wr == 1) PG8_BAR;
        PG8_WAIT_V(4); PG8_BAR;
        PG8_STAGE(PG8_SB(1, 0), cB + kstep, voffB); PG8_STAGE(PG8_SA(1, 0), cA + kstep, voffA); PG8_STAGE(PG8_SB(1, 1), cB + hstep + kstep, voffB);
        PG8_WAIT_V(6); PG8_BAR;
    }
    for (;;) {
        const bool has_next = S.next(ui + 1, nxt);
        const char* nA = has_next ? (const char*)g.A + (size_t)nxt.pm * tstep : cA; const char* nB = has_next ? (const char*)g.Bt + (size_t)nxt.pn * tstep : cB;
        for (int t = 0; t < nt; t += 2) {
            const bool last = (t == nt - 2);
            const char* a1 = cA + (size_t)(t + 1) * kstep;
            const char* a2 = last ? nA : cA + (size_t)(t + 2) * kstep; const char* b2 = last ? nB : cB + (size_t)(t + 2) * kstep;
            const char* a3 = a2 + kstep; const char* b3 = b2 + kstep;
            if (last && has_next) S.a_ready(nxt);
            if constexpr (SP2) {
            PG8_LDB(B0, 0, 0); PG8_LDB(B1, 0, 1); PG8_SCHED; PG8_LDA(At, 0, 0); PG8_STAGE(PG8_SA(1, 1), a1 + hstep, voffA);
            PG8_WAIT_V(8); PG8_WAIT_L(0); PG8_BAR; PG8_MMA(0, 0, At, B0); PG8_MMA(0, 1, At, B1); PG8_BAR; PG8_SCHED;
            PG8_LDA(At, 0, 1); PG8_STAGE(PG8_SB(0, 0), b2, voffB); PG8_STAGE(PG8_SB(0, 1), b2 + hstep, voffB); PG8_STAGE(PG8_SA(0, 0), a2, voffA);
            PG8_WAIT_V(8); PG8_WAIT_L(0); PG8_BAR; PG8_MMA(1, 0, At, B0); PG8_MMA(1, 1, At, B1); PG8_BAR; PG8_SCHED;
            PG8_LDB(B0, 1, 0); PG8_LDB(B1, 1, 1); PG8_SCHED; PG8_LDA(At, 1, 0); PG8_STAGE(PG8_SA(0, 1), a2 + hstep, voffA);
            PG8_WAIT_V(8); PG8_WAIT_L(0); PG8_BAR; PG8_MMA(0, 0, At, B0); PG8_MMA(0, 1, At, B1); PG8_BAR; PG8_SCHED;
            PG8_LDA(At, 1, 1); PG8_STAGE(PG8_SB(1, 0), b3, voffB); PG8_STAGE(PG8_SB(1, 1), b3 + hstep, voffB); PG8_STAGE(PG8_SA(1, 0), a3, voffA);
            PG8_WAIT_V(8); PG8_WAIT_L(0); PG8_BAR; PG8_MMA(1, 0, At, B0); PG8_MMA(1, 1, At, B1); PG8_BAR; PG8_SCHED;
            } else {
            PG8_LDB(B0, 0, 0); PG8_SCHED; PG8_LDA(At, 0, 0); PG8_STAGE(PG8_SA(1, 1), a1 + hstep, voffA);
            PG8_WAIT_L(8); PG8_BAR; PG8_WAIT_L(0); PG8_MMA(0, 0, At, B0); PG8_BAR; PG8_SCHED;
            PG8_LDB(B1, 0, 1); PG8_STAGE(PG8_SB(0, 0), b2, voffB);
            PG8_BAR; PG8_WAIT_L(0); PG8_MMA(0, 1, At, B1); PG8_BAR;
            PG8_LDA(At, 0, 1); PG8_STAGE(PG8_SA(0, 0), a2, voffA);
            PG8_BAR; PG8_WAIT_L(0); PG8_MMA(1, 0, At, B0); PG8_BAR; PG8_SCHED;
            PG8_STAGE(PG8_SB(0, 1), b2 + hstep, voffB);
            PG8_WAIT_V(6); PG8_BAR; PG8_MMA(1, 1, At, B1); PG8_BAR;
            PG8_LDB(B0, 1, 0); PG8_SCHED; PG8_LDA(At, 1, 0); PG8_STAGE(PG8_SA(0, 1), a2 + hstep, voffA);
            PG8_WAIT_L(8); PG8_BAR; PG8_WAIT_L(0); PG8_MMA(0, 0, At, B0); PG8_BAR; PG8_SCHED;
            PG8_LDB(B1, 1, 1); PG8_STAGE(PG8_SB(1, 0), b3, voffB);
            PG8_BAR; PG8_WAIT_L(0); PG8_MMA(0, 1, At, B1); PG8_BAR;
            PG8_LDA(At, 1, 1); PG8_STAGE(PG8_SA(1, 0), a3, voffA);
            PG8_BAR; PG8_WAIT_L(0); PG8_MMA(1, 0, At, B0); PG8_BAR; PG8_SCHED;
            PG8_STAGE(PG8_SB(1, 1), b3 + hstep, voffB);
            PG8_WAIT_V(6); PG8_BAR; PG8_MMA(1, 1, At, B1); PG8_BAR;
            }
        }
        if constexpr (ALIGN_EPI) { if (wr == 0) PG8_BAR; }
        if constexpr (!Epi::AFTER_DRAIN) { E(acc, cur, wr, wc, fr, fq, ui); S.done(cur); }
        if (!has_next) break;
#pragma unroll
        for (int a = 0; a < 2; ++a)
#pragma unroll
            for (int b = 0; b < 2; ++b)
#pragma unroll
                for (int m = 0; m < 4; ++m)
#pragma unroll
                    for (int n = 0; n < 2; ++n) acc[a][b][m][n] = (f32x4){0.f, 0.f, 0.f, 0.f};
        cur = nxt; cA = nA; cB = nB; ++ui;
        if constexpr (ALIGN_EPI) { if (wr == 1) PG8_BAR; }
    }
    PG8_WAIT_V(0);
    if constexpr (!ALIGN_EPI) { if (wr == 0) PG8_BAR; }
    PG8_BAR;
    if constexpr (Epi::AFTER_DRAIN) { E.fused(acc, cur, wr, wc, fr, fq, lds, wid, lane); S.done(cur); }
#undef PG8_SA
#undef PG8_SB
#undef PG8_STAGE
#undef PG8_LDA
#undef PG8_LDB
#undef PG8_MMA
#undef PG8_WAIT_V
#undef PG8_WAIT_L
#undef PG8_BAR
#undef PG8_SCHED
}
}

constexpr int DM = 1024, NBATCH = 4, SEQ = 4096, M = NBATCH * SEQ, DEPTH = 4, SB = 32, DFF = 2816, NH = 8, HD = 64, AW = 512, QKVW = 4608;
constexpr int NWAVES = 8, NTHR = 512;
constexpr float EPS = 1e-6f, NEGF = -1e30f;

constexpr size_t O_YP = 0;
constexpr size_t O_YS = O_YP + (size_t)M * DM;
constexpr size_t O_PSC = O_YS + (size_t)SB * DM;
constexpr size_t O_PK1 = O_PSC + 2ull * NBATCH * 2 * DM;
constexpr size_t O_PK4 = O_PK1 + 2ull * NBATCH * 128 * 1024;
constexpr size_t O_PK16 = O_PK4 + 2ull * NBATCH * 512 * 1024;
constexpr size_t O_PFFN = O_PK16 + 2ull * NBATCH * 2048 * 1024;
constexpr size_t O_SSC = O_PFFN + 4ull * NBATCH * 2 * DFF;
constexpr size_t O_SK1 = O_SSC + 2ull * SB * 2 * DM;
constexpr size_t O_SK4 = O_SK1 + 2ull * SB * 128 * 1024;
constexpr size_t O_SK16 = O_SK4 + 2ull * SB * 512 * 1024;
constexpr size_t O_SFFN = O_SK16 + 2ull * SB * 2048 * 1024;
constexpr size_t O_END = O_SFFN + 4ull * SB * 2 * DFF;
static_assert(O_END == 215949312ull, "output size");

constexpr size_t MiB = 1u << 20;
constexpr size_t WS_CTL = 0;
constexpr size_t WS_INTAB = 28672;
constexpr size_t WS_WIN = 1 * MiB;
constexpr size_t WS_WOUT = WS_WIN + 2ull * 3072 * 1024 * 2;
constexpr size_t WS_WQKV = WS_WOUT + 2ull * 1024 * 1024 * 2;
constexpr size_t WS_WAO = WS_WQKV + 2ull * 4608 * 1024 * 2;
constexpr size_t WS_WGU = WS_WAO + 2ull * 1024 * 512 * 2;
constexpr size_t WS_WDN = WS_WGU + 4ull * 5632 * 1024 * 2;
constexpr size_t WS_HN = WS_WDN + 4ull * 1024 * 2816 * 2;
constexpr size_t WS_ZB = WS_HN + (size_t)M * DM * 2;
constexpr size_t WS_BGB = WS_ZB + (size_t)M * DM * 2;
constexpr size_t WS_UB = WS_BGB + (size_t)M * DM * 2;
constexpr size_t WS_GB = WS_UB + (size_t)M * DM * 2;
constexpr size_t WS_UPB = WS_GB + (size_t)M * DFF * 2;
constexpr size_t WS_ACT = WS_UPB + (size_t)M * DFF * 2;
constexpr size_t WS_QP = WS_ACT + (size_t)M * DFF * 2;
constexpr size_t WS_KP = WS_QP + 3ull * M * AW * 2;
constexpr size_t WS_VP = WS_KP + 3ull * M * AW * 2;
constexpr size_t WS_OUTG = WS_VP + 3ull * M * AW * 2;
constexpr size_t WS_LSE = WS_OUTG + 3ull * M * AW * 2;
constexpr size_t WS_OB = WS_LSE + 3ull * M * 8 * 4;
constexpr size_t WS_XSA = WS_OB + (size_t)M * AW * 2;
constexpr size_t WS_XSB = WS_XSA + (size_t)SB * DM * 4;
constexpr size_t WS_RAWA = WS_XSB + (size_t)SB * DM * 4;
constexpr size_t WS_RAWO = WS_RAWA + (size_t)SB * QKVW * 4;
constexpr size_t WS_RAWGU = WS_RAWO + (size_t)SB * DM * 4;
constexpr size_t WS_RAWDN = WS_RAWGU + (size_t)SB * 2 * DFF * 4;
constexpr size_t WS_OS = WS_RAWDN + (size_t)SB * DM * 4;
constexpr size_t WS_ASM = WS_OS + (size_t)SB * AW * 4;
constexpr size_t WS_ASG = WS_ASM + (size_t)SB * DM * 2;
constexpr size_t WS_ADN = WS_ASG + (size_t)SB * DM * 2;
constexpr size_t WS_ZC = WS_ADN + (size_t)SB * DFF * 2;
constexpr size_t WS_BGS = WS_ZC + (size_t)SB * DM * 4;
constexpr size_t WS_SSS = WS_BGS + (size_t)SB * DM * 4;
constexpr size_t WS_SSP = WS_SSS + 8ull * SB * 8;
constexpr size_t WS_GH = WS_SSP + 8ull * M * 8;
constexpr size_t WS_PRE = WS_GH + 64ull * 2 * DFF * 4;
constexpr size_t WS_UH = WS_PRE + 64ull * 2 * DFF * 4;
constexpr size_t WS_BIAS = WS_UH + 64ull * 2 * DFF * 4;
constexpr size_t WS_END = WS_BIAS + 3ull * 8 * 160 * 4;
static_assert(WS_WIN % 256 == 0 && WS_HN % 256 == 0 && WS_QP % 256 == 0 && WS_XSA % 256 == 0 && WS_OS % 256 == 0, "alignment");

constexpr int LDS_BYTES = 147456;
constexpr int LDS_CTL_OFF = 131072;
constexpr int LDS_HALO_OFF = 131072 + 512;
constexpr int LDS_RTAB_OFF = LDS_HALO_OFF + 4096;

#define LAS __attribute__((address_space(3)))
typedef unsigned short bf16;
typedef float f32x4 __attribute__((ext_vector_type(4)));
typedef float f32x16 __attribute__((ext_vector_type(16)));
typedef short bf16x8 __attribute__((ext_vector_type(8)));
typedef short s16x4 __attribute__((ext_vector_type(4)));
typedef unsigned u32x4 __attribute__((ext_vector_type(4)));
typedef unsigned u32x2 __attribute__((ext_vector_type(2)));
typedef short v4i16_t __attribute__((ext_vector_type(4)));

__device__ __forceinline__ unsigned cvtpk(float lo, float hi) { return pg8::cvt_pk_bf16(lo, hi); }
__device__ __forceinline__ float bflo(unsigned w) { return __uint_as_float(w << 16); }
__device__ __forceinline__ float bfhi(unsigned w) { return __uint_as_float(w & 0xffff0000u); }
template <int MASK> __device__ __forceinline__ float sx(float v) { return __int_as_float(__builtin_amdgcn_ds_swizzle(__float_as_int(v), (MASK << 10) | 0x1f)); }
__device__ __forceinline__ float add32(float v) { const auto r = __builtin_amdgcn_permlane32_swap(__float_as_uint(v), __float_as_uint(v), false, false); return __uint_as_float(r[0]) + __uint_as_float(r[1]); }
__device__ __forceinline__ float max32(float v) { const auto r = __builtin_amdgcn_permlane32_swap(__float_as_uint(v), __float_as_uint(v), false, false); return fmaxf(__uint_as_float(r[0]), __uint_as_float(r[1])); }
__device__ __forceinline__ float wave_sum(float v) { v += sx<1>(v); v += sx<2>(v); v += sx<4>(v); v += sx<8>(v); v += sx<16>(v); return add32(v); }
__device__ __forceinline__ float wave_max(float v) { v = fmaxf(v, sx<1>(v)); v = fmaxf(v, sx<2>(v)); v = fmaxf(v, sx<4>(v)); v = fmaxf(v, sx<8>(v)); v = fmaxf(v, sx<16>(v)); return max32(v); }
typedef float f32x2 __attribute__((ext_vector_type(2)));
__device__ __forceinline__ f32x2 pk_sub(f32x2 a, f32x2 b) { f32x2 r; asm("v_pk_add_f32 %0, %1, %2 neg_lo:[0,1] neg_hi:[0,1]" : "=v"(r) : "v"(a), "v"(b)); return r; }
__device__ __forceinline__ float silu_f(float x) { return x / (1.0f + __expf(-x)); }
__device__ __forceinline__ f32x2 pk_mul2(f32x2 a, f32x2 b) { f32x2 r; asm("v_pk_mul_f32 %0, %1, %2" : "=v"(r) : "v"(a), "v"(b)); return r; }
__device__ __forceinline__ f32x2 pk_add2(f32x2 a, f32x2 b) { f32x2 r; asm("v_pk_add_f32 %0, %1, %2" : "=v"(r) : "v"(a), "v"(b)); return r; }
__device__ __forceinline__ f32x2 silu2(f32x2 x, f32x2 k2, f32x2 one2) {
    const f32x2 t = x * k2; f32x2 e; e[0] = __builtin_amdgcn_exp2f(t[0]); e[1] = __builtin_amdgcn_exp2f(t[1]);
    const f32x2 d = e + one2; f32x2 r; r[0] = __builtin_amdgcn_rcpf(d[0]); r[1] = __builtin_amdgcn_rcpf(d[1]);
    return x * r; }
__device__ __forceinline__ f32x4 silu4(f32x4 x) {
    const f32x2 k2 = (f32x2){-1.4426950408889634f, -1.4426950408889634f}, one2 = (f32x2){1.f, 1.f};
    const f32x2 lo = silu2(__builtin_shufflevector(x, x, 0, 1), k2, one2), hi = silu2(__builtin_shufflevector(x, x, 2, 3), k2, one2);
    return (f32x4){lo[0], lo[1], hi[0], hi[1]}; }
__device__ __forceinline__ float silu_fast(float x) { return x * __builtin_amdgcn_rcpf(1.0f + __expf(-x)); }
__device__ __forceinline__ int t5_bucket(int dist) {
    if (dist < 16) return dist;
    double large = 16.0 + log((double)dist / 16.0) / log(128.0) * 16.0;
    int b = (int)floor(large);
    return b > 31 ? 31 : b;
}

struct Ctx {
    LAS unsigned char* lds; int tid, lane, wave, G, bid;
    const float* const* in;
    float* out; unsigned char* ws;
};

struct TItem { const float* W; int K, N; bf16* WT; int drow, k0, n0; const float* gamma; };
__device__ __forceinline__ void transpose_issue(const TItem& t, int lane, f32x4 (&v)[8]) {
#pragma unroll
    for (int i = 0; i < 8; ++i) { const int kk = (lane >> 3) + 8 * i; v[i] = __builtin_nontemporal_load((const f32x4*)(t.W + (size_t)(t.k0 + kk) * t.N + t.n0 + 4 * (lane & 7))); }
}
__device__ __forceinline__ void transpose_finish(const TItem& t, int lane, const f32x4 (&v)[8], LAS float* scr) {
#pragma unroll
    for (int i = 0; i < 8; ++i) { const int kk = (lane >> 3) + 8 * i; f32x4 w = v[i]; if (t.gamma) w *= t.gamma[t.k0 + kk];
        LAS float* d = scr + kk * 33 + 4 * (lane & 7); d[0] = w[0]; d[1] = w[1]; d[2] = w[2]; d[3] = w[3]; }
    asm volatile("s_waitcnt lgkmcnt(0)" ::: "memory");
    const int c = lane & 7;
#pragma unroll
    for (int j = 0; j < 4; ++j) { const int n = (lane >> 3) + 8 * j; const LAS float* s = scr + (8 * c) * 33 + n;
        u32x4 o; o.x = cvtpk(s[0 * 33], s[1 * 33]); o.y = cvtpk(s[2 * 33], s[3 * 33]); o.z = cvtpk(s[4 * 33], s[5 * 33]); o.w = cvtpk(s[6 * 33], s[7 * 33]);
        *(u32x4*)(t.WT + (size_t)(t.drow + n) * t.K + t.k0 + 8 * c) = o; }
    asm volatile("s_waitcnt lgkmcnt(0)" ::: "memory");
}
__host__ __device__ __forceinline__ int drow_in(int n0) {
    if (n0 < 1024) return 2048 + n0;
    if (n0 < 2048) { const int c = n0 - 1024; return 256 * (c >> 7) + (c & 127); }
    const int c = n0 - 2048; return 256 * (c >> 7) + 128 + (c & 127);
}
__host__ __device__ __forceinline__ int drow_qkv(int n0) {
    const int tile = n0 >> 8, hh = (n0 & 255) >> 6, dd = n0 & 63;
    return 256 * tile + 128 * (dd >> 5) + 32 * hh + (dd & 31);
}
__host__ __device__ __forceinline__ int drow_gu(int n0, int up) { return 256 * (n0 >> 7) + 128 * up + (n0 & 127); }

template <int KEEP> __device__ __forceinline__ void shift_copy_range(const float* src, float* dst, long lo, long hi, int tid) {
    constexpr unsigned PER = (unsigned)(KEEP - 1) * 256u;
    constexpr int UNR = 8;
    for (long i0 = lo + tid; i0 < hi; i0 += UNR * NTHR) { f32x4 v[UNR]; unsigned e[UNR];
#pragma unroll
        for (int q = 0; q < UNR; ++q) { const long i = i0 + q * NTHR; const unsigned ii = (unsigned)(i < hi ? i : hi - 1), seg = ii / PER, off = ii % PER;
            e[q] = seg * (unsigned)(KEEP * 256) + off; v[q] = __builtin_nontemporal_load((const f32x4*)src + 256 + e[q]); }
#pragma unroll
        for (int q = 0; q < UNR; ++q) if (i0 + q * NTHR < hi) __builtin_nontemporal_store(v[q], (f32x4*)dst + e[q]); }
}
constexpr long CP_T1 = 64l * 127 * 256, CP_T4 = 64l * 511 * 256, CP_T16 = 64l * 2047 * 256, CP_TOT = CP_T1 + CP_T4 + CP_T16;
constexpr long CP_CH = 8192;
constexpr int CP_NCH = (int)((CP_TOT + CP_CH - 1) / CP_CH);
constexpr int CW_SOUT = 4608;
constexpr int CW_SGU = 4224;
constexpr int CW_CPNEXT = 3584, CW_DONE = 3648;
__device__ __forceinline__ void copy_chunk(const Ctx& F, int c) {
    const long lo = (long)c * CP_CH, hi = lo + CP_CH < CP_TOT ? lo + CP_CH : CP_TOT;
    { const long l = lo, h = hi < CP_T1 ? hi : CP_T1; if (l < h) shift_copy_range<128>(F.in[3], F.out + O_SK1, l, h, F.tid); }
    { const long l = (lo > CP_T1 ? lo : CP_T1) - CP_T1, h = (hi < CP_T1 + CP_T4 ? hi : CP_T1 + CP_T4) - CP_T1; if (l < h) shift_copy_range<512>(F.in[4], F.out + O_SK4, l, h, F.tid); }
    { const long l = (lo > CP_T1 + CP_T4 ? lo : CP_T1 + CP_T4) - (CP_T1 + CP_T4), h = hi - (CP_T1 + CP_T4); if (l < h) shift_copy_range<2048>(F.in[5], F.out + O_SK16, l, h, F.tid); }
}
__device__ __forceinline__ void copy_while(const Ctx& F, int phase_slot, unsigned ngemm) {
    unsigned* ctl = (unsigned*)F.ws; LAS int* tk = (LAS int*)(F.lds + LDS_CTL_OFF + 64);
    for (;;) {
        __syncthreads();
        if (F.tid == 0) { int c = -1;
            const unsigned d = ngemm == ~0u ? 0u : __hip_atomic_load(ctl + CW_DONE + 64 * phase_slot, __ATOMIC_RELAXED, __HIP_MEMORY_SCOPE_AGENT);
            if (d < ngemm) { c = (int)__hip_atomic_fetch_add(ctl + CW_CPNEXT, 1u, __ATOMIC_RELAXED, __HIP_MEMORY_SCOPE_AGENT); if (c >= CP_NCH) c = -1; }
            *tk = c; }
        __syncthreads();
        const int c = *tk; if (c < 0) break;
        copy_chunk(F, c);
    }
}
__device__ __forceinline__ void gemm_done(const Ctx& F, int phase_slot) {
    __syncthreads(); if (F.tid == 0) __hip_atomic_fetch_add((unsigned*)F.ws + CW_DONE + 64 * phase_slot, 1u, __ATOMIC_RELAXED, __HIP_MEMORY_SCOPE_AGENT);
}

typedef unsigned long long u64;
__device__ __forceinline__ u64 ss_fix(float ss) { return (u64)(ss * 4294967296.0f); }
__device__ __forceinline__ void norm_row(const float* xrow, const float* gamma, bf16* orow, unsigned long long* ss, int lane) {
    const f32x4* xr = (const f32x4*)xrow + lane; (void)gamma;
    f32x4 v[4]; float s = 0.f;
#pragma unroll
    for (int j = 0; j < 4; ++j) { v[j] = xr[64 * j]; s += (v[j].x * v[j].x + v[j].y * v[j].y) + (v[j].z * v[j].z + v[j].w * v[j].w); }
    s = wave_sum(s); if (lane == 0) *ss = ss_fix(s);
    u32x2* o8 = (u32x2*)orow + lane;
#pragma unroll
    for (int j = 0; j < 4; ++j) { u32x2 w; w.x = cvtpk(v[j].x, v[j].y); w.y = cvtpk(v[j].z, v[j].w); o8[64 * j] = w; }
}
__device__ __forceinline__ float rs_of(const u64* p) { const float ss = (float)(*p) * 2.3283064365386963e-10f; return 1.0f / sqrtf(ss * (1.0f / DM) + EPS); }
__device__ __forceinline__ void prologue_phase(const Ctx& F) {
    LAS float* scr = (LAS float*)(F.lds + F.wave * 16384);
    const int gw = F.bid * NWAVES + F.wave, NGW = F.G * NWAVES;
    constexpr int I_IN = 16 * 96, I_OUT = 16 * 32, I_QKV = 16 * 144, I_AO = 8 * 32, I_G = 16 * 88, I_DN = 44 * 32;
    constexpr int T_IN = 2 * I_IN, T_OUT = 2 * I_OUT, T_QKV = 2 * I_QKV, T_AO = 2 * I_AO, T_G = 4 * I_G, T_DN = 4 * I_DN;
    constexpr int NITEMS = T_IN + T_OUT + T_QKV + T_AO + 2 * T_G + T_DN;
    auto decode = [&](int it) -> TItem { TItem t; int r = it; t.gamma = nullptr;
        if (r < T_IN) { const int l = r / I_IN, q = r % I_IN, kb = q / 96, nb = q % 96; t.W = F.in[9] + (size_t)l * 1024 * 3072; t.K = 1024; t.N = 3072; t.WT = (bf16*)(F.ws + WS_WIN) + (size_t)l * 3072 * 1024; t.drow = drow_in(32 * nb); t.k0 = 64 * kb; t.n0 = 32 * nb; t.gamma = F.in[7] + (size_t)(2 * l) * DM; return t; } r -= T_IN;
        if (r < T_OUT) { const int l = r / I_OUT, q = r % I_OUT, kb = q / 32, nb = q % 32; t.W = F.in[11] + (size_t)l * 1024 * 1024; t.K = 1024; t.N = 1024; t.WT = (bf16*)(F.ws + WS_WOUT) + (size_t)l * 1024 * 1024; t.drow = 32 * nb; t.k0 = 64 * kb; t.n0 = 32 * nb; return t; } r -= T_OUT;
        if (r < T_QKV) { const int l = r / I_QKV, q = r % I_QKV, kb = q / 144, nb = q % 144; t.W = F.in[12] + (size_t)l * 1024 * 4608; t.K = 1024; t.N = 4608; t.WT = (bf16*)(F.ws + WS_WQKV) + (size_t)l * 4608 * 1024; t.drow = drow_qkv(32 * nb); t.k0 = 64 * kb; t.n0 = 32 * nb; t.gamma = F.in[7] + (size_t)(2 * l + 1) * DM; return t; } r -= T_QKV;
        if (r < T_AO) { const int l = r / I_AO, q = r % I_AO, kb = q / 32, nb = q % 32; t.W = F.in[15] + (size_t)l * 512 * 1024; t.K = 512; t.N = 1024; t.WT = (bf16*)(F.ws + WS_WAO) + (size_t)l * 1024 * 512; t.drow = 32 * nb; t.k0 = 64 * kb; t.n0 = 32 * nb; return t; } r -= T_AO;
        if (r < 2 * T_G) { const int up = r >= T_G ? 1 : 0; r -= up * T_G; const int l = r / I_G, q = r % I_G, kb = q / 88, nb = q % 88; t.W = F.in[17 + up] + (size_t)l * 1024 * 2816; t.K = 1024; t.N = 2816; t.WT = (bf16*)(F.ws + WS_WGU) + (size_t)l * 5632 * 1024; t.drow = drow_gu(32 * nb, up); t.k0 = 64 * kb; t.n0 = 32 * nb; t.gamma = F.in[8] + (size_t)l * DM; return t; } r -= 2 * T_G;
        { const int l = r / I_DN, q = r % I_DN, kb = q / 32, nb = q % 32; t.W = F.in[21] + (size_t)l * 2816 * 1024; t.K = 2816; t.N = 1024; t.WT = (bf16*)(F.ws + WS_WDN) + (size_t)l * 1024 * 2816; t.drow = 32 * nb; t.k0 = 64 * kb; t.n0 = 32 * nb; return t; } };
    if (gw < NITEMS) { TItem cur = decode(gw); f32x4 va[8]; transpose_issue(cur, F.lane, va);
        for (int it = gw; it < NITEMS; it += NGW) { const bool more = it + NGW < NITEMS; TItem nxt = cur; f32x4 vb[8];
            if (more) { nxt = decode(it + NGW); transpose_issue(nxt, F.lane, vb); }
            transpose_finish(cur, F.lane, va, scr);
            if (more) { cur = nxt;
#pragma unroll
                for (int q = 0; q < 8; ++q) va[q] = vb[q]; } } }
    { f32x4 va[4], vb[4];
      if (gw < M) {
#pragma unroll
          for (int q = 0; q < 4; ++q) va[q] = __builtin_nontemporal_load((const f32x4*)(F.in[0] + (size_t)gw * DM) + F.lane + 64 * q);
          for (int m = gw; m < M; m += NGW) { const bool more = m + NGW < M;
              if (more) {
#pragma unroll
                  for (int q = 0; q < 4; ++q) vb[q] = __builtin_nontemporal_load((const f32x4*)(F.in[0] + (size_t)(m + NGW) * DM) + F.lane + 64 * q); }
              float sacc = 0.f;
#pragma unroll
              for (int q = 0; q < 4; ++q) sacc += (va[q].x * va[q].x + va[q].y * va[q].y) + (va[q].z * va[q].z + va[q].w * va[q].w);
              sacc = wave_sum(sacc); if (F.lane == 0) ((unsigned long long*)(F.ws + WS_SSP))[m] = ss_fix(sacc);
              u32x2* o8 = (u32x2*)((bf16*)(F.ws + WS_HN) + (size_t)m * DM) + F.lane;
#pragma unroll
              for (int q = 0; q < 4; ++q) { u32x2 w; w.x = cvtpk(va[q].x, va[q].y); w.y = cvtpk(va[q].z, va[q].w); o8[64 * q] = w; }
              if (more) {
#pragma unroll
                  for (int q = 0; q < 4; ++q) va[q] = vb[q]; } } } }
    { const size_t gt0 = (size_t)F.bid * NTHR + F.tid, ngt0 = (size_t)F.G * NTHR; unsigned long long* ssp = (unsigned long long*)(F.ws + WS_SSP) + M;
      for (size_t e = gt0; e < 7ull * M; e += ngt0) ssp[e] = 0ull; }
    { const int gw2 = F.bid * NWAVES + F.wave;
      if (gw2 < SB) { const int row = gw2; const f32x4* xr = (const f32x4*)(F.in[1] + (size_t)row * DM) + F.lane; float sacc = 0.f;
          u32x2* o8 = (u32x2*)((bf16*)(F.ws + WS_ASM) + (size_t)row * DM) + F.lane;
#pragma unroll
          for (int q = 0; q < 4; ++q) { const f32x4 v = xr[64 * q]; sacc += (v.x * v.x + v.y * v.y) + (v.z * v.z + v.w * v.w); u32x2 w; w.x = cvtpk(v.x, v.y); w.y = cvtpk(v.z, v.w); o8[64 * q] = w; }
          sacc = wave_sum(sacc); if (F.lane == 0) ((unsigned long long*)(F.ws + WS_SSS))[row] = ss_fix(sacc); }
      if (F.bid == 0 && F.tid >= SB && F.tid < 8 * SB) ((unsigned long long*)(F.ws + WS_SSS))[F.tid] = 0ull; }
    if (F.tid < 15) { const int e = F.bid * 15 + F.tid;
        if (e < 3 * 8 * 160) { const int g = e / 1280, h = (e / 160) & 7, jj = e % 160 - 16;
            ((float*)(F.ws + WS_BIAS))[e] = (jj >= 0 && jj <= 128) ? F.in[16][t5_bucket((1 << (2 * g)) * jj) * 24 + g * 8 + h] : NEGF; } }
    if (F.G * 15 < 3 * 8 * 160 && F.bid == 0) for (int e = F.G * 15 + F.tid; e < 3 * 8 * 160; e += NTHR) { const int g = e / 1280, h = (e / 160) & 7, jj = e % 160 - 16;
        ((float*)(F.ws + WS_BIAS))[e] = (jj >= 0 && jj <= 128) ? F.in[16][t5_bucket((1 << (2 * g)) * jj) * 24 + g * 8 + h] : NEGF; }
}

template <class SCH> __device__ __forceinline__ void preload_rtab(const Ctx& F, const SCH& S, const u64* ssp) {
    LAS float* rt = (LAS float*)(F.lds + LDS_RTAB_OFF);
    if (F.tid < 256) { u64 v[6]; bool ok[6];
#pragma unroll
        for (int i = 0; i < 6; ++i) { pg8::Unit u; ok[i] = S.next(i, u); v[i] = ok[i] ? ssp[u.pm * 256 + F.tid] : 0ull; }
#pragma unroll
        for (int i = 0; i < 6; ++i) if (ok[i]) rt[i * 256 + F.tid] = 1.0f / sqrtf((float)v[i] * 2.3283064365386963e-10f * (1.0f / DM) + EPS); }
    __syncthreads();
}
using pg8::Unit;
typedef f32x4 AccT[2][2][4][2];
__device__ __forceinline__ u32x4 pack8(const f32x4& a, const f32x4& b) { u32x4 w; w.x = cvtpk(a[0], a[1]); w.y = cvtpk(a[2], a[3]); w.z = cvtpk(b[0], b[1]); w.w = cvtpk(b[2], b[3]); return w; }

struct EpiIn {
    static constexpr bool PERM = true, AFTER_DRAIN = false, APERM = false;
    bf16* Z; bf16* BG; float* psc; const LAS float* rt;
    __device__ __forceinline__ void operator()(const f32x4 (&acc)[2][2][4][2], const Unit& u, int wr, int wc, int fr, int fq, int ui) const {
        const int row0 = u.pm * 256 + wr * 64 + fr;
        if (u.pn < 8) {
            const int ch = u.pn * 128 + wc * 32 + 8 * fq;
#pragma unroll
            for (int ai = 0; ai < 2; ++ai)
#pragma unroll
                for (int m = 0; m < 4; ++m) { const int row = row0 + ai * 128 + m * 16; const float r = rt[ui * 256 + (row & 255)], r2 = r * r;
                    const f32x4 z0 = (acc[ai][0][m][0] * acc[ai][1][m][0]) * r2, z1 = (acc[ai][0][m][1] * acc[ai][1][m][1]) * r2;
                    *(u32x4*)(Z + (size_t)row * DM + ch) = pack8(z0, z1);
                    const int t = row & (SEQ - 1);
                    if (t >= SEQ - 2) { float* p = psc + ((size_t)(row >> 12) * 2 + (t - (SEQ - 2))) * DM + ch; *(f32x4*)p = z0; *(f32x4*)(p + 4) = z1; } }
        } else {
#pragma unroll
            for (int ai = 0; ai < 2; ++ai)
#pragma unroll
                for (int m = 0; m < 4; ++m) { const int row = row0 + ai * 128 + m * 16; const float r = rt[ui * 256 + (row & 255)];
#pragma unroll
                    for (int bj = 0; bj < 2; ++bj) { const int ch = (u.pn - 8) * 256 + bj * 128 + wc * 32 + 8 * fq;
                        *(u32x4*)(BG + (size_t)row * DM + ch) = pack8(acc[ai][bj][m][0] * r, acc[ai][bj][m][1] * r); } }
        }
    }
};
struct EpiRes {
    static constexpr bool PERM = true, AFTER_DRAIN = false, APERM = false;
    const float* xin32; bf16* xb; u64* ss_next; float* yout;
    __device__ __forceinline__ void operator()(const f32x4 (&acc)[2][2][4][2], const Unit& u, int wr, int wc, int fr, int fq, int ui) const {
        const int row0 = u.pm * 256 + wr * 64 + fr, col0 = u.pn * 256 + wc * 32 + 8 * fq;
        if (xin32) {
#pragma unroll
            for (int ai = 0; ai < 2; ++ai) {
                f32x4 x[4][2][2];
#pragma unroll
                for (int m = 0; m < 4; ++m)
#pragma unroll
                    for (int bj = 0; bj < 2; ++bj) { const float* p = xin32 + (size_t)(row0 + ai * 128 + m * 16) * DM + col0 + bj * 128; x[m][bj][0] = __builtin_nontemporal_load((const f32x4*)p); x[m][bj][1] = __builtin_nontemporal_load((const f32x4*)(p + 4)); }
#pragma unroll
                for (int m = 0; m < 4; ++m) { const int row = row0 + ai * 128 + m * 16; const size_t off = (size_t)row * DM + col0; float ss = 0.f;
#pragma unroll
                    for (int bj = 0; bj < 2; ++bj) { const f32x4 x0 = x[m][bj][0] + acc[ai][bj][m][0], x1 = x[m][bj][1] + acc[ai][bj][m][1];
                        *(u32x4*)(xb + off + bj * 128) = pack8(x0, x1);
                        ss += (x0[0] * x0[0] + x0[1] * x0[1]) + (x0[2] * x0[2] + x0[3] * x0[3]) + (x1[0] * x1[0] + x1[1] * x1[1]) + (x1[2] * x1[2] + x1[3] * x1[3]); }
                    ss += sx<16>(ss); ss = add32(ss); if (fq == 0) atomicAdd(ss_next + row, ss_fix(ss)); }
                asm volatile("" ::: "memory"); }
        } else {
            u32x4 w[2][4][2];
#pragma unroll
            for (int ai = 0; ai < 2; ++ai)
#pragma unroll
                for (int m = 0; m < 4; ++m)
#pragma unroll
                    for (int bj = 0; bj < 2; ++bj) w[ai][m][bj] = *(const u32x4*)(xb + (size_t)(row0 + ai * 128 + m * 16) * DM + col0 + bj * 128);
#pragma unroll
            for (int ai = 0; ai < 2; ++ai) {
#pragma unroll
                for (int m = 0; m < 4; ++m) { const int row = row0 + ai * 128 + m * 16; const size_t off = (size_t)row * DM + col0; float ss = 0.f;
#pragma unroll
                    for (int bj = 0; bj < 2; ++bj) { const u32x4 q = w[ai][m][bj];
                        const f32x4 x0 = (f32x4){bflo(q.x), bfhi(q.x), bflo(q.y), bfhi(q.y)} + acc[ai][bj][m][0], x1 = (f32x4){bflo(q.z), bfhi(q.z), bflo(q.w), bfhi(q.w)} + acc[ai][bj][m][1];
                        if (yout) { __builtin_nontemporal_store(x0, (f32x4*)(yout + off + bj * 128)); __builtin_nontemporal_store(x1, (f32x4*)(yout + off + bj * 128 + 4)); }
                        else { *(u32x4*)(xb + off + bj * 128) = pack8(x0, x1);
                            ss += (x0[0] * x0[0] + x0[1] * x0[1]) + (x0[2] * x0[2] + x0[3] * x0[3]) + (x1[0] * x1[0] + x1[1] * x1[1]) + (x1[2] * x1[2] + x1[3] * x1[3]); } }
                    if (!yout) { ss += sx<16>(ss); ss = add32(ss); if (fq == 0) atomicAdd(ss_next + row, ss_fix(ss)); } }
                asm volatile("" ::: "memory"); }
        }
    }
};
struct EpiGU {
    static constexpr bool PERM = true, AFTER_DRAIN = false, APERM = false;
    bf16* GB; bf16* UPB; float* pffn; const u64* ssp;
    __device__ __forceinline__ void operator()(const f32x4 (&acc)[2][2][4][2], const Unit& u, int wr, int wc, int fr, int fq, int ui) const {
        const int row0 = u.pm * 256 + wr * 64 + fr, ch = u.pn * 128 + wc * 32 + 8 * fq;
#pragma unroll
        for (int ai = 0; ai < 2; ++ai)
#pragma unroll
            for (int m = 0; m < 4; ++m) { const int row = row0 + ai * 128 + m * 16; const float r = rs_of(ssp + row);
                const f32x4 g0 = acc[ai][0][m][0] * r, g1 = acc[ai][0][m][1] * r;
                *(u32x4*)(GB + (size_t)row * DFF + ch) = pack8(g0, g1);
                *(u32x4*)(UPB + (size_t)row * DFF + ch) = pack8(acc[ai][1][m][0] * r, acc[ai][1][m][1] * r);
                const int t = row & (SEQ - 1);
                if (t >= SEQ - 2) { float* p = pffn + ((size_t)(row >> 12) * 2 + (t - (SEQ - 2))) * DFF + ch; *(f32x4*)p = g0; *(f32x4*)(p + 4) = g1; } }
    }
};
struct EpiQKV {
    static constexpr bool PERM = true, AFTER_DRAIN = false, APERM = false;
    bf16* QP; const float* qn; long kdiff; float* outp; int j; const LAS float* rt;
    __device__ __forceinline__ void operator()(const f32x4 (&acc)[2][2][4][2], const Unit& u, int wr, int wc, int fr, int fq, int ui) const {
        const int g = u.pn / 6, s = (u.pn % 6) >> 1, h = 4 * (u.pn & 1) + wc;
        const int lg = 2 * g, dil = 1 << lg, Lg = SEQ >> lg, keep = 128 << lg;
        const int row0 = u.pm * 256 + wr * 64 + fr;
        bf16* dstb = QP + (size_t)s * (3ull * M * AW);
        const size_t pkoff = (g == 0 ? O_PK1 : (g == 1 ? O_PK4 : O_PK16)) + (size_t)j * NBATCH * keep * 1024;
        float* pk = outp + pkoff;
        f32x4 w[2][2];
        { const float* nw = qn + (s == 1 ? kdiff : 0l);
#pragma unroll
            for (int bj = 0; bj < 2; ++bj)
#pragma unroll
                for (int n = 0; n < 2; ++n) w[bj][n] = *(const f32x4*)(nw + 32 * bj + 8 * fq + 4 * n); }
#pragma unroll
        for (int ai = 0; ai < 2; ++ai)
#pragma unroll
            for (int m = 0; m < 4; ++m) { const int row = row0 + ai * 128 + m * 16, b = row >> 12, t = row & (SEQ - 1);
                f32x4 v[2][2]; const float rr = rt[ui * 256 + (row & 255)];
#pragma unroll
                for (int bj = 0; bj < 2; ++bj)
#pragma unroll
                    for (int n = 0; n < 2; ++n) v[bj][n] = acc[ai][bj][m][n] * rr;
                if (s < 2) { float ss = 0.f;
#pragma unroll
                    for (int bj = 0; bj < 2; ++bj)
#pragma unroll
                        for (int n = 0; n < 2; ++n) ss += (v[bj][n][0] * v[bj][n][0] + v[bj][n][1] * v[bj][n][1]) + (v[bj][n][2] * v[bj][n][2] + v[bj][n][3] * v[bj][n][3]);
                    ss += sx<16>(ss); ss = add32(ss);
                    const float r = 1.0f / sqrtf(ss * (1.0f / HD) + EPS);
#pragma unroll
                    for (int bj = 0; bj < 2; ++bj)
#pragma unroll
                        for (int n = 0; n < 2; ++n) v[bj][n] = (v[bj][n] * r) * w[bj][n]; }
                const int res = t & (dil - 1), tt = t >> lg;
                const size_t prow = (size_t)((g * NBATCH + b) * NH + h) * SEQ + (size_t)res * Lg + tt;
#pragma unroll
                for (int bj = 0; bj < 2; ++bj) *(u32x4*)(dstb + prow * HD + 32 * bj + 8 * fq) = pack8(v[bj][0], v[bj][1]);
                if (s >= 1 && t >= SEQ - keep) {
                    float* p = pk + ((((size_t)b * keep + (t - (SEQ - keep))) * 2 + (s - 1)) * NH + h) * HD + 8 * fq;
#pragma unroll
                    for (int bj = 0; bj < 2; ++bj)
#pragma unroll
                        for (int n = 0; n < 2; ++n) __builtin_nontemporal_store(v[bj][n], (f32x4*)(p + 32 * bj + 4 * n)); } }
    }
};

__device__ __forceinline__ float dpp_shr1(float old, float src) { return __int_as_float(__builtin_amdgcn_update_dpp(__float_as_int(old), __float_as_int(src), 0x111, 0xf, 0xf, false)); }
__device__ __forceinline__ float dpp_shr2(float old, float src) { return __int_as_float(__builtin_amdgcn_update_dpp(__float_as_int(old), __float_as_int(src), 0x112, 0xf, 0xf, false)); }
__device__ __forceinline__ float dpp_ror1(float src) { return __int_as_float(__builtin_amdgcn_update_dpp(0, __float_as_int(src), 0x121, 0xf, 0xf, false)); }
__device__ __forceinline__ float dpp_ror2(float src) { return __int_as_float(__builtin_amdgcn_update_dpp(0, __float_as_int(src), 0x122, 0xf, 0xf, false)); }
struct EpiGUF {
    static constexpr bool PERM = true, AFTER_DRAIN = false, APERM = true;
    bf16* ACT; float* pffn; const LAS float* rt; const float* cw; const float* cb; float* GH; float* PRE; float* UH; LAS float* halo;
    __device__ __forceinline__ void operator()(const f32x4 (&acc)[2][2][4][2], const Unit& u, int wr, int wc, int fr, int fq, int ui) const {
        const int row0 = u.pm * 256 + wr * 64 + 4 * fr, ch = u.pn * 128 + wc * 32 + 8 * fq;
        f32x4 w0[2], w1[2], w2[2], bb[2];
#pragma unroll
        for (int n = 0; n < 2; ++n) { w0[n] = *(const f32x4*)(cw + ch + 4 * n); w1[n] = *(const f32x4*)(cw + DFF + ch + 4 * n); w2[n] = *(const f32x4*)(cw + 2 * DFF + ch + 4 * n); bb[n] = *(const f32x4*)(cb + ch + 4 * n); }
        f32x4 G[2][4][2], U[2][4][2];
#pragma unroll
        for (int ai = 0; ai < 2; ++ai)
#pragma unroll
            for (int m = 0; m < 4; ++m) { const float r = rt[ui * 256 + wr * 64 + 4 * fr + ai * 128 + m];
#pragma unroll
                for (int n = 0; n < 2; ++n) { G[ai][m][n] = acc[ai][0][m][n] * r; U[ai][m][n] = acc[ai][1][m][n] * r; } }
        if (fr == 15) {
#pragma unroll
            for (int ai = 0; ai < 2; ++ai)
#pragma unroll
                for (int q = 0; q < 2; ++q)
#pragma unroll
                    for (int n = 0; n < 2; ++n) *(LAS f32x4*)(halo + ((((ai * 2 + wr) * 4 + wc) * 4 + fq) * 2 + q) * 8 + 4 * n) = G[ai][2 + q][n];
            if (wr == 1) {
#pragma unroll
                for (int q = 0; q < 2; ++q) { float* gp = GH + ((size_t)u.pm * 2 + q) * DFF + ch; *(f32x4*)gp = G[1][2 + q][0]; *(f32x4*)(gp + 4) = G[1][2 + q][1];
                    if ((u.pm & 15) == 15) { float* p = pffn + ((size_t)(u.pm >> 4) * 2 + q) * DFF + ch; *(f32x4*)p = G[1][2 + q][0]; *(f32x4*)(p + 4) = G[1][2 + q][1]; } } } }
        asm volatile("s_waitcnt lgkmcnt(0)" ::: "memory"); __builtin_amdgcn_s_barrier(); asm volatile("" ::: "memory");
#pragma unroll
        for (int ai = 0; ai < 2; ++ai) {
            f32x4 h63[2], h62[2];
            const bool have = (wr == 1) || (ai == 1);
            const int sai = wr == 1 ? ai : 0, swr = wr == 1 ? 0 : 1;
#pragma unroll
            for (int n = 0; n < 2; ++n) { const LAS float* hp = halo + ((((sai * 2 + swr) * 4 + wc) * 4 + fq) * 2) * 8 + 4 * n;
                const f32x4 r63 = *(const LAS f32x4*)(hp + 8), r62 = *(const LAS f32x4*)(hp);
                h63[n] = have ? r63 : (f32x4){0.f, 0.f, 0.f, 0.f}; h62[n] = have ? r62 : (f32x4){0.f, 0.f, 0.f, 0.f}; }
            f32x4 o[4][2], pr0[2], pr1[2];
#pragma unroll
            for (int n = 0; n < 2; ++n) {
                const f32x4 g0 = G[ai][0][n], g1 = G[ai][1][n], g2 = G[ai][2][n], g3 = G[ai][3][n];
                f32x4 s3, s2;
#pragma unroll
                for (int e = 0; e < 4; ++e) { s3[e] = dpp_shr1(h63[n][e], g3[e]); s2[e] = dpp_shr1(h62[n][e], g2[e]); }
                const f32x4 a = w0[n], b = w1[n], c = w2[n], d = bb[n];
                const f32x4 p0 = a * s2 + (b * s3 + (c * g0 + d)), p1 = a * s3 + (b * g0 + (c * g1 + d)), p2 = a * g0 + (b * g1 + (c * g2 + d)), p3 = a * g1 + (b * g2 + (c * g3 + d));
                pr0[n] = p0; pr1[n] = p1;
                o[0][n] = silu4(p0) * U[ai][0][n]; o[1][n] = silu4(p1) * U[ai][1][n]; o[2][n] = silu4(p2) * U[ai][2][n]; o[3][n] = silu4(p3) * U[ai][3][n]; }
#pragma unroll
            for (int m = 0; m < 4; ++m) *(u32x4*)(ACT + (size_t)(row0 + ai * 128 + m) * DFF + ch) = pack8(o[m][0], o[m][1]);
            if (ai == 0 && wr == 0 && fr == 0) {
                float* pp = PRE + ((size_t)u.pm * 2) * DFF + ch; *(f32x4*)pp = pr0[0]; *(f32x4*)(pp + 4) = pr0[1]; *(f32x4*)(pp + DFF) = pr1[0]; *(f32x4*)(pp + DFF + 4) = pr1[1];
                float* up = UH + ((size_t)u.pm * 2) * DFF + ch; *(f32x4*)up = U[0][0][0]; *(f32x4*)(up + 4) = U[0][0][1]; *(f32x4*)(up + DFF) = U[0][1][0]; *(f32x4*)(up + DFF + 4) = U[0][1][1]; }
        }
    }
};
__device__ __forceinline__ void ffn_fixup_panel(const Ctx& F, int pm, const float* GH, const float* PRE, const float* UH, const float* cw, bf16* ACT) {
    if ((pm & 15) != 0) {
        for (int e = F.tid; e < 2 * 352; e += NTHR) { const int rr = e / 352, c = (e % 352) * 8;
            const float* pp = PRE + ((size_t)pm * 2 + rr) * DFF + c; const float* up = UH + ((size_t)pm * 2 + rr) * DFF + c;
            const float* g0 = GH + ((size_t)(pm - 1) * 2 + 0) * DFF + c; const float* g1 = GH + ((size_t)(pm - 1) * 2 + 1) * DFF + c;
            const f32x4 pa = *(const f32x4*)pp, pb = *(const f32x4*)(pp + 4), ua = *(const f32x4*)up, ub = *(const f32x4*)(up + 4), ga = *(const f32x4*)g1, gb = *(const f32x4*)(g1 + 4);
            const f32x4 w0a = *(const f32x4*)(cw + c), w0b = *(const f32x4*)(cw + c + 4);
            f32x4 xa = pa + w0a * ga, xb = pb + w0b * gb;
            if (rr == 0) { const f32x4 ha = *(const f32x4*)g0, hb = *(const f32x4*)(g0 + 4), w1a = *(const f32x4*)(cw + DFF + c), w1b = *(const f32x4*)(cw + DFF + c + 4);
                xa = pa + w0a * ha + w1a * ga; xb = pb + w0b * hb + w1b * gb; }
            f32x4 oa, ob;
#pragma unroll
            for (int q = 0; q < 4; ++q) { oa[q] = silu_f(xa[q]) * ua[q]; ob[q] = silu_f(xb[q]) * ub[q]; }
            *(u32x4*)(ACT + (size_t)(pm * 256 + rr) * DFF + c) = pack8(oa, ob); }
    }
    asm volatile("s_waitcnt vmcnt(0)" ::: "memory"); __syncthreads();
}

struct TripletOrder {
    int G, c;
    __device__ __forceinline__ void init(int G_, int c_) { G = G_; c = c_; }
    __device__ __forceinline__ bool next(int i, Unit& u) const {
        const int T = c + (i / 3) * G, k = i % 3; if (T >= 256) return false;
        const int xcd = T & 7, loc = T >> 3, cgp = loc & 3;
        u.pm = xcd * 8 + (loc >> 2); u.pn = k < 2 ? 2 * cgp + k : 8 + cgp; return true; }
    __device__ __forceinline__ void a_ready(const Unit&) const {}
    __device__ __forceinline__ void done(const Unit&) const {}
};
struct EpiInF {
    static constexpr bool PERM = true, AFTER_DRAIN = false, APERM = true;
    bf16* CB; bf16* UBo; float* psc; const LAS float* rt; const float* cw; float* ZH; float* PREC; float* BGH; LAS float* halo;
    __device__ __forceinline__ void operator()(const f32x4 (&acc)[2][2][4][2], const Unit& u, int wr, int wc, int fr, int fq, int ui) const {
        const int row0 = u.pm * 256 + wr * 64 + 4 * fr;
        if (u.pn < 8) {
            const int ch = u.pn * 128 + wc * 32 + 8 * fq;
            f32x4 w0[2], w1[2], w2[2];
#pragma unroll
            for (int n = 0; n < 2; ++n) { w0[n] = *(const f32x4*)(cw + ch + 4 * n); w1[n] = *(const f32x4*)(cw + DM + ch + 4 * n); w2[n] = *(const f32x4*)(cw + 2 * DM + ch + 4 * n); }
            f32x4 Z[2][4][2];
#pragma unroll
            for (int ai = 0; ai < 2; ++ai)
#pragma unroll
                for (int m = 0; m < 4; ++m) { const float r = rt[ui * 256 + wr * 64 + 4 * fr + ai * 128 + m], r2 = r * r;
#pragma unroll
                    for (int n = 0; n < 2; ++n) Z[ai][m][n] = (acc[ai][0][m][n] * acc[ai][1][m][n]) * r2; }
            if (fr == 15) {
#pragma unroll
                for (int ai = 0; ai < 2; ++ai)
#pragma unroll
                    for (int q = 0; q < 2; ++q)
#pragma unroll
                        for (int n = 0; n < 2; ++n) *(LAS f32x4*)(halo + ((((ai * 2 + wr) * 4 + wc) * 4 + fq) * 2 + q) * 8 + 4 * n) = Z[ai][2 + q][n];
                if (wr == 1) {
#pragma unroll
                    for (int q = 0; q < 2; ++q) { float* gp = ZH + ((size_t)u.pm * 2 + q) * DM + ch; *(f32x4*)gp = Z[1][2 + q][0]; *(f32x4*)(gp + 4) = Z[1][2 + q][1];
                        if ((u.pm & 15) == 15) { float* p = psc + ((size_t)(u.pm >> 4) * 2 + q) * DM + ch; *(f32x4*)p = Z[1][2 + q][0]; *(f32x4*)(p + 4) = Z[1][2 + q][1]; } } } }
            asm volatile("s_waitcnt lgkmcnt(0)" ::: "memory"); __builtin_amdgcn_s_barrier(); asm volatile("" ::: "memory");
#pragma unroll
            for (int ai = 0; ai < 2; ++ai) {
                f32x4 h63[2], h62[2];
                const bool have = (wr == 1) || (ai == 1);
                const int sai = wr == 1 ? ai : 0, swr = wr == 1 ? 0 : 1;
#pragma unroll
                for (int n = 0; n < 2; ++n) { const LAS float* hp = halo + ((((sai * 2 + swr) * 4 + wc) * 4 + fq) * 2) * 8 + 4 * n;
                    const f32x4 r63 = *(const LAS f32x4*)(hp + 8), r62 = *(const LAS f32x4*)(hp);
                    h63[n] = have ? r63 : (f32x4){0.f, 0.f, 0.f, 0.f}; h62[n] = have ? r62 : (f32x4){0.f, 0.f, 0.f, 0.f}; }
                f32x4 o[4][2];
#pragma unroll
                for (int n = 0; n < 2; ++n) {
                    const f32x4 g0 = Z[ai][0][n], g1 = Z[ai][1][n], g2 = Z[ai][2][n], g3 = Z[ai][3][n];
                    f32x4 s3, s2;
#pragma unroll
                    for (int e = 0; e < 4; ++e) { s3[e] = dpp_shr1(h63[n][e], g3[e]); s2[e] = dpp_shr1(h62[n][e], g2[e]); }
                    const f32x4 a = w0[n], b = w1[n], c = w2[n];
                    o[0][n] = a * s2 + (b * s3 + c * g0); o[1][n] = a * s3 + (b * g0 + c * g1); o[2][n] = a * g0 + (b * g1 + c * g2); o[3][n] = a * g1 + (b * g2 + c * g3); }
#pragma unroll
                for (int m = 0; m < 4; ++m) *(u32x4*)(CB + (size_t)(row0 + ai * 128 + m) * DM + ch) = pack8(o[m][0], o[m][1]);
                if (ai == 0 && wr == 0 && fr == 0) {
                    float* pp = PREC + ((size_t)u.pm * 2) * DM + ch; *(f32x4*)pp = o[0][0]; *(f32x4*)(pp + 4) = o[0][1]; *(f32x4*)(pp + DM) = o[1][0]; *(f32x4*)(pp + DM + 4) = o[1][1]; }
            }
        } else {
            const int cb0 = (u.pn - 8) * 256 + wc * 32 + 8 * fq;
            asm volatile("s_waitcnt vmcnt(0)" ::: "memory");
#pragma unroll
            for (int ai = 0; ai < 2; ++ai) {
                u32x4 cv[4][2];
#pragma unroll
                for (int m = 0; m < 4; ++m)
#pragma unroll
                    for (int bj = 0; bj < 2; ++bj) cv[m][bj] = *(const u32x4*)(CB + (size_t)(row0 + ai * 128 + m) * DM + cb0 + bj * 128);
#pragma unroll
                for (int m = 0; m < 4; ++m) { const float r = rt[ui * 256 + wr * 64 + 4 * fr + ai * 128 + m];
#pragma unroll
                    for (int bj = 0; bj < 2; ++bj) { const u32x4 q = cv[m][bj];
                        const f32x4 b0 = acc[ai][bj][m][0] * r, b1 = acc[ai][bj][m][1] * r;
                        const f32x4 c0 = (f32x4){bflo(q.x), bfhi(q.x), bflo(q.y), bfhi(q.y)}, c1 = (f32x4){bflo(q.z), bfhi(q.z), bflo(q.w), bfhi(q.w)};
                        *(u32x4*)(UBo + (size_t)(row0 + ai * 128 + m) * DM + cb0 + bj * 128) = pack8(b0 * c0, b1 * c1);
                        if (ai == 0 && wr == 0 && fr == 0 && m < 2) { float* bp = BGH + ((size_t)u.pm * 2 + m) * DM + cb0 + bj * 128; *(f32x4*)bp = b0; *(f32x4*)(bp + 4) = b1; } } }
            }
        }
    }
};
__device__ __forceinline__ void sc_fixup_panel(const Ctx& F, int pm, const float* ZH, const float* PREC, const float* BGH, const float* cw, bf16* UBo) {
    if ((pm & 15) != 0 && F.tid < 256) { const int rr = F.tid >> 7, c = (F.tid & 127) * 8;
        const float* pp = PREC + ((size_t)pm * 2 + rr) * DM + c; const float* bp = BGH + ((size_t)pm * 2 + rr) * DM + c;
        const float* g0 = ZH + ((size_t)(pm - 1) * 2 + 0) * DM + c; const float* g1 = ZH + ((size_t)(pm - 1) * 2 + 1) * DM + c;
        const f32x4 pa = *(const f32x4*)pp, pb = *(const f32x4*)(pp + 4), ba = *(const f32x4*)bp, bb = *(const f32x4*)(bp + 4), ga = *(const f32x4*)g1, gb = *(const f32x4*)(g1 + 4);
        const f32x4 ha = *(const f32x4*)g0, hb = *(const f32x4*)(g0 + 4);
        const f32x4 w0a = *(const f32x4*)(cw + c), w0b = *(const f32x4*)(cw + c + 4), w1a = *(const f32x4*)(cw + DM + c), w1b = *(const f32x4*)(cw + DM + c + 4);
        f32x4 xa = pa + w0a * ga, xb = pb + w0b * gb;
        if (rr == 0) { xa = pa + w0a * ha + w1a * ga; xb = pb + w0b * hb + w1b * gb; }
        *(u32x4*)(UBo + (size_t)(pm * 256 + rr) * DM + c) = pack8(ba * xa, bb * xb); }
    asm volatile("s_waitcnt vmcnt(0)" ::: "memory"); __syncthreads();
}

__device__ __forceinline__ void conv_ew_phase(const Ctx& F, const bf16* Z, const bf16* BG, const float* cw  , bf16* UB, int ewid, int ewn) {
    if (ewid < 0) return;
    const size_t gt = (size_t)ewid * NTHR + F.tid, ngt = (size_t)ewn * NTHR;
    const int c = (int)(gt & 127) * 8;
    const f32x4 w0a = *(const f32x4*)(cw + c), w0b = *(const f32x4*)(cw + c + 4), w1a = *(const f32x4*)(cw + DM + c), w1b = *(const f32x4*)(cw + DM + c + 4), w2a = *(const f32x4*)(cw + 2 * DM + c), w2b = *(const f32x4*)(cw + 2 * DM + c + 4);
    constexpr size_t TOT = (size_t)M * 128; constexpr int UN = 4;
    for (size_t i0 = gt; i0 < TOT; i0 += UN * ngt) { u32x4 z2[UN], z1[UN], z0[UN], bg[UN];
#pragma unroll
        for (int q = 0; q < UN; ++q) { const size_t i = i0 + q * ngt < TOT ? i0 + q * ngt : gt; const int row = (int)(i >> 7), t = row & (SEQ - 1);
            z2[q] = *(const u32x4*)(Z + (size_t)row * DM + c); z1[q] = (u32x4){0u, 0u, 0u, 0u}; z0[q] = (u32x4){0u, 0u, 0u, 0u};
            if (t >= 1) z1[q] = *(const u32x4*)(Z + (size_t)(row - 1) * DM + c);
            if (t >= 2) z0[q] = *(const u32x4*)(Z + (size_t)(row - 2) * DM + c);
            bg[q] = *(const u32x4*)(BG + (size_t)row * DM + c); }
#pragma unroll
        for (int q = 0; q < UN; ++q) { const size_t i = i0 + q * ngt; if (i < TOT) { const int row = (int)(i >> 7); float o[8];
#pragma unroll
            for (int p = 0; p < 4; ++p) { const float wl0 = p < 2 ? w0a[2 * p] : w0b[2 * p - 4], wh0 = p < 2 ? w0a[2 * p + 1] : w0b[2 * p - 3];
                const float wl1 = p < 2 ? w1a[2 * p] : w1b[2 * p - 4], wh1 = p < 2 ? w1a[2 * p + 1] : w1b[2 * p - 3];
                const float wl2 = p < 2 ? w2a[2 * p] : w2b[2 * p - 4], wh2 = p < 2 ? w2a[2 * p + 1] : w2b[2 * p - 3];
                o[2 * p] = bflo(bg[q][p]) * (wl0 * bflo(z0[q][p]) + wl1 * bflo(z1[q][p]) + wl2 * bflo(z2[q][p]));
                o[2 * p + 1] = bfhi(bg[q][p]) * (wh0 * bfhi(z0[q][p]) + wh1 * bfhi(z1[q][p]) + wh2 * bfhi(z2[q][p])); }
            u32x4 w; w.x = cvtpk(o[0], o[1]); w.y = cvtpk(o[2], o[3]); w.z = cvtpk(o[4], o[5]); w.w = cvtpk(o[6], o[7]);
            *(u32x4*)(UB + (size_t)row * DM + c) = w; } } }
}
__device__ __forceinline__ void ffn_ew_phase(const Ctx& F, const bf16* GB, const bf16* UPB, const float* cw  , const float* cb, bf16* ACT) {
    const size_t gt = (size_t)F.bid * NTHR + F.tid, ngt = (size_t)F.G * NTHR;
    for (size_t i = gt; i < (size_t)M * 352; i += ngt) { const int row = (int)(i / 352), c = (int)(i % 352) * 8, t = row & (SEQ - 1);
        const u32x4 g2 = *(const u32x4*)(GB + (size_t)row * DFF + c);
        u32x4 g1 = (u32x4){0u, 0u, 0u, 0u}, g0 = (u32x4){0u, 0u, 0u, 0u};
        if (t >= 1) g1 = *(const u32x4*)(GB + (size_t)(row - 1) * DFF + c);
        if (t >= 2) g0 = *(const u32x4*)(GB + (size_t)(row - 2) * DFF + c);
        const u32x4 up = *(const u32x4*)(UPB + (size_t)row * DFF + c);
        float w0[8], w1[8], w2[8], bb[8];
        *(f32x4*)(w0) = *(const f32x4*)(cw + c); *(f32x4*)(w0 + 4) = *(const f32x4*)(cw + c + 4);
        *(f32x4*)(w1) = *(const f32x4*)(cw + DFF + c); *(f32x4*)(w1 + 4) = *(const f32x4*)(cw + DFF + c + 4);
        *(f32x4*)(w2) = *(const f32x4*)(cw + 2 * DFF + c); *(f32x4*)(w2 + 4) = *(const f32x4*)(cw + 2 * DFF + c + 4);
        *(f32x4*)(bb) = *(const f32x4*)(cb + c); *(f32x4*)(bb + 4) = *(const f32x4*)(cb + c + 4);
        float o[8];
#pragma unroll
        for (int q = 0; q < 4; ++q) {
            const float a = w0[2 * q] * bflo(g0[q]) + w1[2 * q] * bflo(g1[q]) + w2[2 * q] * bflo(g2[q]) + bb[2 * q];
            const float b = w0[2 * q + 1] * bfhi(g0[q]) + w1[2 * q + 1] * bfhi(g1[q]) + w2[2 * q + 1] * bfhi(g2[q]) + bb[2 * q + 1];
            o[2 * q] = silu_f(a) * bflo(up[q]); o[2 * q + 1] = silu_f(b) * bfhi(up[q]); }
        u32x4 w; w.x = cvtpk(o[0], o[1]); w.y = cvtpk(o[2], o[3]); w.z = cvtpk(o[4], o[5]); w.w = cvtpk(o[6], o[7]);
        *(u32x4*)(ACT + (size_t)row * DFF + c) = w; }
}
__device__ __forceinline__ void merge_phase(const Ctx& F, const bf16* OUTG, const float* LSE, bf16* OB, int ewid, int ewn) {
    if (ewid < 0) return;
    const size_t gt = (size_t)ewid * NTHR + F.tid, ngt = (size_t)ewn * NTHR;
    const int c = (int)(gt & 63) * 8, h = c >> 6;
    constexpr size_t TOT = (size_t)M * 64; constexpr int UN = 3;
    for (size_t i0 = gt; i0 < TOT; i0 += UN * ngt) { float l0[UN], l1[UN], l2[UN]; u32x4 a[UN], b[UN], d[UN];
#pragma unroll
        for (int q = 0; q < UN; ++q) { const size_t i = i0 + q * ngt < TOT ? i0 + q * ngt : gt; const int row = (int)(i >> 6);
            l0[q] = LSE[(size_t)row * 8 + h]; l1[q] = LSE[((size_t)M + row) * 8 + h]; l2[q] = LSE[((size_t)2 * M + row) * 8 + h];
            a[q] = *(const u32x4*)(OUTG + (size_t)row * AW + c); b[q] = *(const u32x4*)(OUTG + ((size_t)M + row) * AW + c); d[q] = *(const u32x4*)(OUTG + ((size_t)2 * M + row) * AW + c); }
#pragma unroll
        for (int q = 0; q < UN; ++q) { const size_t i = i0 + q * ngt; if (i < TOT) { const int row = (int)(i >> 6);
            const float mx = fmaxf(l0[q], fmaxf(l1[q], l2[q])); float e0 = __expf(l0[q] - mx), e1 = __expf(l1[q] - mx), e2 = __expf(l2[q] - mx); const float inv = 1.0f / (e0 + e1 + e2); e0 *= inv; e1 *= inv; e2 *= inv;
            u32x4 w;
#pragma unroll
            for (int p = 0; p < 4; ++p) w[p] = cvtpk(e0 * bflo(a[q][p]) + e1 * bflo(b[q][p]) + e2 * bflo(d[q][p]), e0 * bfhi(a[q][p]) + e1 * bfhi(b[q][p]) + e2 * bfhi(d[q][p]));
            *(u32x4*)(OB + (size_t)row * AW + c) = w; } } }
}

constexpr int KV_ROWB = 144;
constexpr int LDS_VS = 384 * KV_ROWB, LDS_TAB = 2 * LDS_VS;
__device__ __forceinline__ s16x4 vtr(const LAS unsigned char* p) { return __builtin_bit_cast(s16x4, __builtin_amdgcn_ds_read_tr16_b64_v4i16((LAS v4i16_t*)p)); }
struct AttnItem { int g, b, h, res, c, lg, tt0; size_t rowbase; };
__device__ __forceinline__ AttnItem attn_decode(int item) {
    AttnItem t; t.g = item >> 9; const int rem = item & 511, bh = rem >> 4, sub = rem & 15; t.b = bh >> 3; t.h = bh & 7; t.lg = 2 * t.g;
    t.res = t.g == 0 ? 0 : (t.g == 1 ? (sub >> 2) : sub); t.c = t.g == 0 ? sub : (t.g == 1 ? (sub & 3) : 0);
    t.rowbase = (size_t)((t.g * NBATCH + t.b) * NH + t.h) * SEQ + (size_t)t.res * (SEQ >> t.lg); t.tt0 = t.c * 256; return t;
}
__device__ __forceinline__ void attn_issue(const AttnItem& t, const bf16* KP, const bf16* VP, int tid, u32x4 (&kr)[6], u32x4 (&vr)[6], const bf16* QP, const float* biasw, bf16x8 (&qf)[2][2], float& tabv) {
    { const int lane = tid & 63, wave = tid >> 6, qi = lane & 15, grp = lane >> 4;
#pragma unroll
      for (int q2 = 0; q2 < 2; ++q2) { const bf16* qrow = QP + (t.rowbase + t.tt0 + 16 * (wave * 2 + q2) + qi) * HD; qf[q2][0] = *(const bf16x8*)(qrow + 8 * grp); qf[q2][1] = *(const bf16x8*)(qrow + 32 + 8 * grp); }
      tabv = biasw[(t.g * 8 + t.h) * 160 + (tid < 160 ? tid : 0)]; }
#pragma unroll
    for (int q = 0; q < 6; ++q) { const int idx = tid + q * NTHR, r = idx >> 3, ch = idx & 7, tt = t.tt0 - 128 + r;
        kr[q] = (u32x4){0u, 0u, 0u, 0u}; vr[q] = (u32x4){0u, 0u, 0u, 0u};
        if (tt >= 0) { kr[q] = *(const u32x4*)(KP + (t.rowbase + tt) * HD + ch * 8); vr[q] = *(const u32x4*)(VP + (t.rowbase + tt) * HD + ch * 8); } }
}
__device__ __forceinline__ void attn_phase(const Ctx& F, const bf16* QP, const bf16* KP, const bf16* VP, bf16* OUTG, float* LSE) {
    LAS float* tab = (LAS float*)(F.lds + LDS_TAB);
    const int lane = F.lane, qi = lane & 15, grp = lane >> 4;
    const int x3 = qi + 141 - 4 * grp, tcopy = (x3 & 3) * 160, xb4 = x3 & ~3;
    u32x4 kr[6], vr[6]; bf16x8 qnx[2][2]; float tabv = 0.f;
    const float* biasw = (const float*)(F.ws + WS_BIAS);
    if (F.bid < 1536) { const AttnItem t0 = attn_decode(F.bid); attn_issue(t0, KP, VP, F.tid, kr, vr, QP, biasw, qnx, tabv); }
    for (int item = F.bid; item < 1536; item += F.G) {
        const AttnItem t = attn_decode(item);
        const int g = t.g, b = t.b, h = t.h, res = t.res, c = t.c, lg = t.lg, dil = 1 << lg, tt0 = t.tt0; const size_t rowbase = t.rowbase;
        __syncthreads();
#pragma unroll
        for (int q = 0; q < 6; ++q) { const int idx = F.tid + q * NTHR, r = idx >> 3, ch = idx & 7;
            *(LAS u32x4*)(F.lds + r * KV_ROWB + ch * 16) = kr[q]; *(LAS u32x4*)(F.lds + LDS_VS + r * KV_ROWB + ch * 16) = vr[q]; }
        if (F.tid < 160) { const float tv = tabv * 1.4426950408889634f;
#pragma unroll
            for (int cc = 0; cc < 4; ++cc) if (F.tid >= cc) tab[cc * 160 + F.tid - cc] = tv; }
        __syncthreads();
        bf16x8 qfa[2][2];
#pragma unroll
        for (int q2 = 0; q2 < 2; ++q2) { qfa[q2][0] = qnx[q2][0]; qfa[q2][1] = qnx[q2][1]; }
        if (item + F.G < 1536) { const AttnItem tn = attn_decode(item + F.G); attn_issue(tn, KP, VP, F.tid, kr, vr, QP, biasw, qnx, tabv); }
#pragma unroll
        for (int q2 = 0; q2 < 2; ++q2) {
            const int qt = F.wave * 2 + q2, tq = tt0 + 16 * qt + qi;
            const bf16x8 qf0 = qfa[q2][0], qf1 = qfa[q2][1];
            f32x4 s[9];
            const LAS unsigned char* kbase = F.lds + (16 * qt + qi) * KV_ROWB + grp * 16;
#pragma unroll
            for (int kb = 0; kb < 9; ++kb) {
                const bf16x8 k0 = *(const LAS bf16x8*)(kbase + kb * 16 * KV_ROWB), k1 = *(const LAS bf16x8*)(kbase + kb * 16 * KV_ROWB + 64);
                f32x4 z = (f32x4){0.f, 0.f, 0.f, 0.f};
                z = __builtin_amdgcn_mfma_f32_16x16x32_bf16(k0, qf0, z, 0, 0, 0);
                s[kb] = __builtin_amdgcn_mfma_f32_16x16x32_bf16(k1, qf1, z, 0, 0, 0); }
            const LAS unsigned char* vbase = F.lds + LDS_VS + (16 * qt + 4 * grp + (qi >> 2)) * KV_ROWB + (qi & 3) * 8;
            bf16x8 vfa[4], vfb[4];
#pragma unroll
            for (int d = 0; d < 4; ++d) { const s16x4 lo_ = vtr(vbase + d * 32), hi_ = vtr(vbase + 16 * KV_ROWB + d * 32); vfa[d] = (bf16x8){lo_[0], lo_[1], lo_[2], lo_[3], hi_[0], hi_[1], hi_[2], hi_[3]}; }
            f32x4 bv[9];
#pragma unroll
            for (int kb = 0; kb < 9; ++kb)
                { const f32x4 t4 = *(const LAS f32x4*)(tab + tcopy + (xb4 - 16 * kb)); bv[kb] = (f32x4){t4[3], t4[2], t4[1], t4[0]}; }
            float mx = -3.0e38f;
            { const float kc = 0.125f * 1.4426950408889634f; const f32x4 kc4 = (f32x4){kc, kc, kc, kc};
#pragma unroll
              for (int kb = 0; kb < 9; ++kb) s[kb] = s[kb] * kc4 + bv[kb]; }
            { const float limf = c == 0 ? (float)(128 - 16 * qt - 4 * grp) : -1.0e9f;
              float ngv = NEGF; asm volatile("" : "+v"(ngv)); const f32x4 neg4 = (f32x4){ngv, ngv, ngv, ngv};
#pragma unroll
              for (int kb = 0; kb < 9; ++kb) { f32x4 t;
#pragma unroll
                  for (int r = 0; r < 4; ++r) t[r] = __builtin_amdgcn_fmed3f(limf - (float)(16 * kb + r), 0.f, 1.f);
                  s[kb] = t * neg4 + s[kb]; } }
#pragma unroll
            for (int kb = 0; kb < 9; ++kb) mx = fmaxf(mx, fmaxf(fmaxf(s[kb][0], s[kb][1]), fmaxf(s[kb][2], s[kb][3])));
            mx = fmaxf(mx, sx<16>(mx)); mx = max32(mx);
            f32x4 sum4 = (f32x4){0.f, 0.f, 0.f, 0.f}; const f32x2 mx2 = (f32x2){mx, mx};
#pragma unroll
            for (int kb = 0; kb < 9; ++kb) { const f32x2 dl = __builtin_shufflevector(s[kb], s[kb], 0, 1) - mx2, dh = __builtin_shufflevector(s[kb], s[kb], 2, 3) - mx2; const f32x4 dlt = (f32x4){dl[0], dl[1], dh[0], dh[1]}; f32x4 p;
#pragma unroll
                for (int r = 0; r < 4; ++r) p[r] = __builtin_amdgcn_exp2f(dlt[r]);
                s[kb] = p; sum4 += p; }
            float sum = (sum4[0] + sum4[1]) + (sum4[2] + sum4[3]);
            sum += sx<16>(sum); sum = add32(sum);
            f32x4 o[4];
#pragma unroll
            for (int d = 0; d < 4; ++d) o[d] = (f32x4){0.f, 0.f, 0.f, 0.f};
#define ATT_LOADV(kk_, arr_) do { _Pragma("unroll") for (int d = 0; d < 4; ++d) { \
                const s16x4 lo_ = vtr(vbase + (32 * (kk_)) * KV_ROWB + d * 32), hi_ = (kk_) < 4 ? vtr(vbase + (32 * (kk_) + 16) * KV_ROWB + d * 32) : lo_;   \
                arr_[d] = (bf16x8){lo_[0], lo_[1], lo_[2], lo_[3], hi_[0], hi_[1], hi_[2], hi_[3]}; } } while (0)
#pragma unroll
            for (int kk = 0; kk < 5; ++kk) {
                u32x4 pw; pw.x = cvtpk(s[2 * kk][0], s[2 * kk][1]); pw.y = cvtpk(s[2 * kk][2], s[2 * kk][3]);
                if (kk < 4) { pw.z = cvtpk(s[2 * kk + 1 < 9 ? 2 * kk + 1 : 8][0], s[2 * kk + 1 < 9 ? 2 * kk + 1 : 8][1]); pw.w = cvtpk(s[2 * kk + 1 < 9 ? 2 * kk + 1 : 8][2], s[2 * kk + 1 < 9 ? 2 * kk + 1 : 8][3]); }
                else { pw.z = 0u; pw.w = 0u; }
                const bf16x8 pf = __builtin_bit_cast(bf16x8, pw);
                if ((kk & 1) == 0) { if (kk < 4) ATT_LOADV(kk + 1, vfb);
#pragma unroll
                    for (int d = 0; d < 4; ++d) o[d] = __builtin_amdgcn_mfma_f32_16x16x32_bf16(vfa[d], pf, o[d], 0, 0, 0); }
                else { ATT_LOADV(kk + 1, vfa);
#pragma unroll
                    for (int d = 0; d < 4; ++d) o[d] = __builtin_amdgcn_mfma_f32_16x16x32_bf16(vfb[d], pf, o[d], 0, 0, 0); } }
#undef ATT_LOADV
            const float inv = 1.0f / sum;
            const size_t token = (size_t)b * SEQ + (size_t)tq * dil + res;
            bf16* op = OUTG + ((size_t)g * M + token) * AW + h * HD + 4 * grp;
#pragma unroll
            for (int d = 0; d < 4; ++d) { u32x2 w; w.x = cvtpk(o[d][0] * inv, o[d][1] * inv); w.y = cvtpk(o[d][2] * inv, o[d][3] * inv); *(u32x2*)(op + 16 * d) = w; }
            if (grp == 0) LSE[((size_t)g * M + token) * 8 + h] = (mx + __builtin_amdgcn_logf(sum)) * 0.6931471805599453f;
        }
    }
}

__device__ __forceinline__ void sample_attn_phase(const Ctx& F, int j, const float* RAW, float* OS) {
    LAS float* sq = (LAS float*)(F.lds);
    LAS float* sk = sq + 192;
    LAS float* sv = sk + 192;
    LAS float* slog = sv + 192;
    LAS float* sstat = slog + 396;
    LAS float* spart = sstat + 8;
    const int lane = F.lane;
    const float* biasw = (const float*)(F.ws + WS_BIAS);
    for (int it = F.G - 1 - F.bid; it < SB * NH; it += F.G) {
        const int b = it >> 3, h = it & 7;
        __syncthreads();
        for (int u = F.wave; u < 9; u += NWAVES) { const int g = u / 3, s = u % 3, d = lane;
            const int col = (g * 6 + s * 2 + (h >> 2)) * 256 + (d >> 5) * 128 + (h & 3) * 32 + (d & 31);
            float v = RAW[(size_t)b * QKVW + col];
            if (s < 2) { const float ss = wave_sum(v * v); const float r = 1.0f / sqrtf(ss * (1.0f / HD) + EPS); v = (v * r) * F.in[s == 0 ? 13 : 14][j * HD + d]; }
            (s == 0 ? sq : (s == 1 ? sk : sv))[g * 64 + d] = v;
            if (s >= 1) { const int keep = 128 << (2 * g); const size_t ob = g == 0 ? O_SK1 : (g == 1 ? O_SK4 : O_SK16);
                F.out[ob + ((((size_t)(j * SB + b) * keep + (keep - 1)) * 2 + (s - 1)) * NH + h) * HD + d] = v; } }
        __syncthreads();
        { f32x4 kv[13];
#pragma unroll
          for (int it2 = 0; it2 < 13; ++it2) { const int kidx = it2 * 32 + F.wave * 4 + (lane >> 4); const int kx = kidx < 387 ? kidx : 386, g = kx / 129, jj = kx % 129, keep = 128 << (2 * g), dil = 1 << (2 * g);
              const float* cache = F.in[3 + g];
              const int rowi = jj == 0 ? 0 : (keep - dil * jj);
              kv[it2] = *(const f32x4*)(cache + ((((size_t)(j * SB + b) * keep + rowi) * 2 + 0) * NH + h) * HD + 4 * (lane & 15)); }
#pragma unroll
          for (int it2 = 0; it2 < 13; ++it2) { const int kidx = it2 * 32 + F.wave * 4 + (lane >> 4); const bool act = kidx < 387; const int kx = act ? kidx : 386, g = kx / 129, jj = kx % 129;
              f32x4 kk = kv[it2]; if (jj == 0) kk = *(const LAS f32x4*)(sk + g * 64 + 4 * (lane & 15));
              const f32x4 qv = *(const LAS f32x4*)(sq + g * 64 + 4 * (lane & 15));
              float d = (kk[0] * qv[0] + kk[1] * qv[1]) + (kk[2] * qv[2] + kk[3] * qv[3]);
              d += sx<1>(d); d += sx<2>(d); d += sx<4>(d); d += sx<8>(d);
              if (act && (lane & 15) == 0) slog[g * 132 + jj] = d * 0.125f + biasw[(g * 8 + h) * 160 + 16 + jj]; } }
        __syncthreads();
        if (F.wave < 3) { const int g = F.wave;
            const float v0 = slog[g * 132 + lane], v1 = slog[g * 132 + 64 + lane], v2 = lane == 0 ? slog[g * 132 + 128] : -3.0e38f;
            const float m = wave_max(fmaxf(v0, fmaxf(v1, v2)));
            const float e0 = __expf(v0 - m), e1 = __expf(v1 - m), e2 = lane == 0 ? __expf(v2 - m) : 0.f;
            const float ssum = wave_sum(e0 + e1 + e2);
            slog[g * 132 + lane] = e0; slog[g * 132 + 64 + lane] = e1; if (lane == 0) { slog[g * 132 + 128] = e2; sstat[g * 2] = m + __logf(ssum); sstat[g * 2 + 1] = 1.0f / ssum; } }
        __syncthreads();
        { float a[3] = {0.f, 0.f, 0.f};
#pragma unroll
          for (int g = 0; g < 3; ++g) { const int keep = 128 << (2 * g), dil = 1 << (2 * g); const float* cache = F.in[3 + g];
              const float* vb = cache + ((((size_t)(j * SB + b) * keep) * 2 + 1) * NH + h) * HD + lane;
              float vv[17];
#pragma unroll
              for (int q = 0; q < 17; ++q) { const int jj = F.wave + 8 * q; const int rowi = (jj == 0 || jj > 128) ? 0 : (keep - dil * jj); vv[q] = vb[(size_t)rowi * 2 * NH * HD]; }
#pragma unroll
              for (int q = 0; q < 17; ++q) { const int jj = F.wave + 8 * q; if (jj <= 128) { const float v = jj == 0 ? sv[g * 64 + lane] : vv[q]; a[g] += slog[g * 132 + jj] * v; } } }
#pragma unroll
          for (int g = 0; g < 3; ++g) spart[(F.wave * 3 + g) * 64 + lane] = a[g]; }
        __syncthreads();
        if (F.tid < 64) { const int d = F.tid;
            const float l0 = sstat[0], l1 = sstat[2], l2 = sstat[4], mx = fmaxf(l0, fmaxf(l1, l2));
            const float w0 = __expf(l0 - mx), w1 = __expf(l1 - mx), w2 = __expf(l2 - mx), inv = 1.0f / (w0 + w1 + w2);
            float o0 = 0.f, o1 = 0.f, o2 = 0.f;
#pragma unroll
            for (int w = 0; w < 8; ++w) { o0 += spart[(w * 3 + 0) * 64 + d]; o1 += spart[(w * 3 + 1) * 64 + d]; o2 += spart[(w * 3 + 2) * 64 + d]; }
            OS[(size_t)b * AW + h * HD + d] = (w0 * o0 * sstat[1] + w1 * o1 * sstat[3] + w2 * o2 * sstat[5]) * inv; }
    }
    __syncthreads();
}

__device__ __forceinline__ bf16x8 pack_frag(const float (&x)[8]) { u32x4 w; w.x = cvtpk(x[0], x[1]); w.y = cvtpk(x[2], x[3]); w.z = cvtpk(x[4], x[5]); w.w = cvtpk(x[6], x[7]); return __builtin_bit_cast(bf16x8, w); }
__device__ __forceinline__ int tile_row(int tile, int c, int NP) { return tile < NP ? 256 * (tile >> 3) + 16 * (tile & 7) + (c & 15) + 128 * (c >> 4) : tile * 32 + c; }
template <class LA, class EP> __device__ __forceinline__ void skinny_gemm(const Ctx& F, const LA& la, const EP& ep, const bf16* Wt, int N, int K, int NP, int first, int nworkers) {
    const int ntiles = N >> 5;
    if (first < 0 || first >= nworkers || first >= ntiles) return;
    LAS float* red = (LAS float*)F.lds;
    const int lane = F.lane, col = lane & 31, half = lane >> 5, kslice = K >> 3, kbeg = F.wave * kslice;
    for (int tile = first; tile < ntiles; tile += nworkers) {
        f32x16 acc;
#pragma unroll
        for (int r = 0; r < 16; ++r) acc[r] = 0.f;
        const bf16* wrow = Wt + (size_t)tile_row(tile, col, NP) * K + kbeg + 16 * half;
#pragma unroll 4
        for (int kb = 0; kb < kslice; kb += 32) {
            const bf16x8 b0 = *(const bf16x8*)(wrow + kb), b1 = *(const bf16x8*)(wrow + kb + 8);
            const bf16x8 a0 = la.frag(col, kbeg + kb + 16 * half), a1 = la.frag(col, kbeg + kb + 16 * half + 8);
            acc = __builtin_amdgcn_mfma_f32_32x32x16_bf16(a0, b0, acc, 0, 0, 0);
            acc = __builtin_amdgcn_mfma_f32_32x32x16_bf16(a1, b1, acc, 0, 0, 0); }
        __syncthreads();
#pragma unroll
        for (int r = 0; r < 16; ++r) { const int row = (r & 3) + 8 * (r >> 2) + 4 * half; red[(F.wave * 32 + row) * 33 + col] = acc[r]; }
        __syncthreads();
        { const int row = F.tid >> 4, c0 = F.tid & 15; float v0 = 0.f, v1 = 0.f;
#pragma unroll
          for (int w = 0; w < 8; ++w) { v0 += red[(w * 32 + row) * 33 + c0]; v1 += red[(w * 32 + row) * 33 + c0 + 16]; }
          ep(tile, row, c0, v0, v1); }
    }
    __syncthreads();
}
struct LoadBf16 { const bf16* A; int K;
    __device__ __forceinline__ bf16x8 frag(int row, int k) const { return *(const bf16x8*)(A + (size_t)row * K + k); } };
struct LoadMulF32 { const float* P; const float* Q; int K;
    __device__ __forceinline__ bf16x8 frag(int row, int k) const { const f32x4 p0 = *(const f32x4*)(P + (size_t)row * K + k), p1 = *(const f32x4*)(P + (size_t)row * K + k + 4), q0 = *(const f32x4*)(Q + (size_t)row * K + k), q1 = *(const f32x4*)(Q + (size_t)row * K + k + 4);
        float x[8];
#pragma unroll
        for (int q = 0; q < 4; ++q) { x[q] = p0[q] * q0[q]; x[4 + q] = p1[q] * q1[q]; }
        return pack_frag(x); } };
struct LoadF32 { const float* P; int K;
    __device__ __forceinline__ bf16x8 frag(int row, int k) const { const f32x4 p0 = *(const f32x4*)(P + (size_t)row * K + k), p1 = *(const f32x4*)(P + (size_t)row * K + k + 4);
        float x[8];
#pragma unroll
        for (int q = 0; q < 4; ++q) { x[q] = p0[q]; x[4 + q] = p1[q]; }
        return pack_frag(x); } };
__device__ __forceinline__ bf16 f2bf1(float x) { return (bf16)(cvtpk(x, 0.f) & 0xffffu); }
struct EpiSIn { const u64* ss; const float* hist; const float* cw; float* ZC; float* BGs; float* hout;
    __device__ __forceinline__ void operator()(int tile, int row, int c0, float v0, float v1) const {
        const float r = rs_of(ss + row);
        if (tile < 64) { const int ch = 128 * (tile >> 3) + 16 * (tile & 7) + c0; const float z = (r * v0) * (r * v1);
            const float h0 = hist[((size_t)row * 2 + 0) * DM + ch], h1 = hist[((size_t)row * 2 + 1) * DM + ch];
            ZC[(size_t)row * DM + ch] = cw[ch] * h0 + cw[DM + ch] * h1 + cw[2 * DM + ch] * z;
            hout[((size_t)row * 2 + 0) * DM + ch] = h1; hout[((size_t)row * 2 + 1) * DM + ch] = z; }
        else { const int ch = (tile - 64) * 32 + c0; BGs[(size_t)row * DM + ch] = r * v0; BGs[(size_t)row * DM + ch + 16] = r * v1; } } };
struct EpiSRes { const float* xs_in; float* xs_out; const float* gamma_next; bf16* as_next; u64* ss_next; float* yout;
    __device__ __forceinline__ void operator()(int tile, int row, int c0, float v0, float v1) const {
        const int col = tile * 32 + c0; const float x0 = xs_in[(size_t)row * DM + col] + v0, x1 = xs_in[(size_t)row * DM + col + 16] + v1;
        if (xs_out) { xs_out[(size_t)row * DM + col] = x0; xs_out[(size_t)row * DM + col + 16] = x1; }
        if (yout) { yout[(size_t)row * DM + col] = x0; yout[(size_t)row * DM + col + 16] = x1; }
        if (as_next) { as_next[(size_t)row * DM + col] = f2bf1(x0); as_next[(size_t)row * DM + col + 16] = f2bf1(x1);
            float p = x0 * x0 + x1 * x1; p += sx<1>(p); p += sx<2>(p); p += sx<4>(p); p += sx<8>(p);
            if (c0 == 0) atomicAdd(ss_next + row, ss_fix(p)); } } };
struct EpiSGU { const u64* ss; const float* hist; const float* cw; const float* cb; bf16* ADN; float* hout;
    __device__ __forceinline__ void operator()(int tile, int row, int c0, float v0, float v1) const {
        const float r = rs_of(ss + row);
        const int ch = 128 * (tile >> 3) + 16 * (tile & 7) + c0; const float G = r * v0, U = r * v1;
        const float h0 = hist[((size_t)row * 2 + 0) * DFF + ch], h1 = hist[((size_t)row * 2 + 1) * DFF + ch];
        const float pre = cw[ch] * h0 + cw[DFF + ch] * h1 + cw[2 * DFF + ch] * G + cb[ch];
        ADN[(size_t)row * DFF + ch] = f2bf1(silu_f(pre) * U);
        hout[((size_t)row * 2 + 0) * DFF + ch] = h1; hout[((size_t)row * 2 + 1) * DFF + ch] = G; } };
struct EpiSQKV { const u64* ss; float* RAW;
    __device__ __forceinline__ void operator()(int tile, int row, int c0, float v0, float v1) const {
        const float r = rs_of(ss + row);
        RAW[(size_t)row * QKVW + tile * 32 + c0] = r * v0; RAW[(size_t)row * QKVW + tile * 32 + c0 + 16] = r * v1; } };


#define XB_TMO      128
#define XB_XCNT(j)  (256  + 64 * (j))
#define XB_XSUB(j)  (1280 + 64 * (j))
#define XB_XGEN(j)  (2304 + 64 * (j))
#define XB_TOP      3328
#define XB_TOPGEN   3392
#define XCD_BAR_WORDS 3456
#define XB_SPIN_CAP (1u << 18)

__device__ __forceinline__ unsigned xb_ld(unsigned* p)              { return __hip_atomic_load(p, __ATOMIC_RELAXED, __HIP_MEMORY_SCOPE_AGENT); }
__device__ __forceinline__ unsigned xb_add(unsigned* p, unsigned v) { return __hip_atomic_fetch_add(p, v, __ATOMIC_RELAXED, __HIP_MEMORY_SCOPE_AGENT); }
__device__ __forceinline__ unsigned xb_xcc_id() { return (unsigned)__builtin_amdgcn_s_getreg((3 << 11) | 20) & 0xFu; }
#define XB_SPIN(cond, bar) do { unsigned _sp = 0; while (cond) { __builtin_amdgcn_s_sleep(1); \
    if ((++_sp & 255u) == 0u) { if (xb_ld(&(bar)[XB_TMO])) break; if (_sp > XB_SPIN_CAP) { atomicAdd(&(bar)[XB_TMO], 1u); break; } } } } while (0)

struct XcdBarrier {
    unsigned* bar; unsigned x;
    volatile LAS unsigned* st;
};

__device__ __forceinline__ XcdBarrier xcd_barrier_post(unsigned* bar, volatile LAS unsigned* st) {
    XcdBarrier b; b.bar = bar; b.x = xb_xcc_id(); b.st = st;
    if (threadIdx.x == 0) (void)xb_add(&bar[XB_XCNT(b.x)], 1u);
    return b;
}
__device__ __forceinline__ void xcd_barrier_complete(unsigned* bar, unsigned x, unsigned& nloc, unsigned& nx) {
    const unsigned G = gridDim.x * gridDim.y * gridDim.z;
    unsigned sum, cnt, mine, sp = 0u;
    for (;;) {
        sum = 0u; cnt = 0u; mine = 0u;
#pragma unroll
        for (unsigned j = 0; j < 16; ++j) { const unsigned c = xb_ld(&bar[XB_XCNT(j)]); sum += c; cnt += (c > 0u) ? 1u : 0u; mine = (j == x) ? c : mine; }
        if (sum == G) break;
        __builtin_amdgcn_s_sleep(1);
        if ((++sp & 255u) == 0u) { if (xb_ld(&bar[XB_TMO])) break; if (sp > XB_SPIN_CAP) { atomicAdd(&bar[XB_TMO], 1u); break; } }
    }
    nloc = mine > 0u ? mine : 1u; nx = cnt > 0u ? cnt : 1u;
}

__device__ __forceinline__ void xcd_barrier(const XcdBarrier& b) {
    asm volatile("s_waitcnt vmcnt(0)" ::: "memory");
    __syncthreads();
    if (threadIdx.x == 0) {
        unsigned* bar = b.bar;
        __builtin_amdgcn_s_waitcnt(0);
        unsigned nloc = b.st[0], nx = b.st[1];
        if (nloc == 0u) { xcd_barrier_complete(bar, b.x, nloc, nx); b.st[0] = nloc; b.st[1] = nx; }
        const unsigned old = xb_add(&bar[XB_XSUB(b.x)], 1u);
        const unsigned gen = old / nloc;
        if (old + 1u == (gen + 1u) * nloc) {
            __builtin_amdgcn_fence(__ATOMIC_RELEASE, "agent");
            asm volatile("s_waitcnt vmcnt(0)" ::: "memory");
            const unsigned og = xb_add(&bar[XB_TOP], 1u);
            const unsigned tg = og / nx;
            if (og + 1u == (tg + 1u) * nx) xb_add(&bar[XB_TOPGEN], 1u);
            else XB_SPIN(xb_ld(&bar[XB_TOPGEN]) == tg, bar);
            __builtin_amdgcn_fence(__ATOMIC_ACQUIRE, "agent");
            xb_add(&bar[XB_XGEN(b.x)], 1u);
            asm volatile("s_waitcnt vmcnt(0)" ::: "memory");
        } else {
            XB_SPIN(xb_ld(&bar[XB_XGEN(b.x)]) == gen, bar);
            __builtin_amdgcn_fence(__ATOMIC_ACQUIRE, "agent");
            asm volatile("s_waitcnt vmcnt(0)" ::: "memory");
        }
    }
    __syncthreads();
}


#ifndef WGM_IN
#define WGM_IN 8
#endif
#ifndef WGM_QKV
#define WGM_QKV 8
#endif
#ifndef WGM_GU
#define WGM_GU 8
#endif
#ifndef WGM_MIX
#define WGM_MIX 8
#endif
#ifndef WGM_DN
#define WGM_DN 8
#endif
#ifndef PG8_SP2
#define PG8_SP2 true
#endif
struct Args { const float* in[22]; float* out; unsigned char* ws; int ph_lo, ph_hi; };
enum { I_XP = 0, I_XS, I_STSC, I_C1, I_C4, I_C16, I_STFFN, I_NMIX, I_NFFN, I_WIN, I_SCCW, I_WOUT, I_WQKV, I_QN, I_KN, I_WAO, I_RELB, I_WGATE, I_WUP, I_FCW, I_FCB, I_WDN };
__device__ __forceinline__ Ctx fresh(const Ctx& F0) {
    Ctx P = F0; int t; asm volatile("v_mbcnt_lo_u32_b32 %0, -1, 0\n\tv_mbcnt_hi_u32_b32 %0, -1, %0" : "=v"(t)); t += F0.wave * 64; P.tid = t; P.lane = t & 63; P.wave = __builtin_amdgcn_readfirstlane(t >> 6);
    long z = 0; int bb = F0.bid; asm volatile("" : "+s"(z), "+s"(bb)); P.bid = bb;
    P.ws = F0.ws + z; P.out = F0.out + z; P.in = F0.in + z; return P;
}
#define HN ((bf16*)(ws + WS_HN))
#define ZB ((bf16*)(ws + WS_ZB))
#define BGB ((bf16*)(ws + WS_BGB))
#define UB ((bf16*)(ws + WS_UB))
#define GB ((bf16*)(ws + WS_GB))
#define UPB ((bf16*)(ws + WS_UPB))
#define ACT ((bf16*)(ws + WS_ACT))
#define QP ((bf16*)(ws + WS_QP))
#define KP ((bf16*)(ws + WS_KP))
#define VP ((bf16*)(ws + WS_VP))
#define OUTG ((bf16*)(ws + WS_OUTG))
#define LSE ((float*)(ws + WS_LSE))
#define OB ((bf16*)(ws + WS_OB))
#define XSA ((float*)(ws + WS_XSA))
#define XSB ((float*)(ws + WS_XSB))
#define RAWA ((float*)(ws + WS_RAWA))
#define RAWO ((float*)(ws + WS_RAWO))
#define RAWGU ((float*)(ws + WS_RAWGU))
#define RAWDN ((float*)(ws + WS_RAWDN))
#define OS ((float*)(ws + WS_OS))
#define ASM ((bf16*)(ws + WS_ASM))
#define ASG ((bf16*)(ws + WS_ASG))
#define ADN ((bf16*)(ws + WS_ADN))
#define ZC ((float*)(ws + WS_ZC))
#define BGS ((float*)(ws + WS_BGS))
#define SSP(n) ((u64*)(ws + WS_SSP) + (size_t)(n) * M)
#define SSS(n) ((u64*)(ws + WS_SSS) + (n) * SB)
#define XS_IN(s) ((s) == 0 ? F.in[I_XS] : (((s) & 1) ? (const float*)XSA : (const float*)XSB))
#define XS_OUT(s) (((s) & 1) ? XSB : XSA)
#define XRES (F.out + O_YP)
__global__ void __launch_bounds__(NTHR, 2) mega_fwd(Args args) {
    extern __shared__ __attribute__((aligned(16))) unsigned char lds_raw[];
    cg::grid_group grid = cg::this_grid();
    Ctx F0;
    F0.lds = (LAS unsigned char*)lds_raw; F0.tid = threadIdx.x; F0.lane = F0.tid & 63; F0.wave = __builtin_amdgcn_readfirstlane(F0.tid >> 6); F0.G = gridDim.x; F0.bid = blockIdx.x;
    F0.in = args.in; F0.out = args.out; F0.ws = args.ws;
    constexpr int NPHASES = 21;
    const int lo = args.ph_lo, hi = args.ph_hi < NPHASES ? args.ph_hi : NPHASES; int ph = 0;
    if (F0.tid < 64) ((LAS unsigned*)(F0.lds + LDS_CTL_OFF))[F0.tid] = 0u;
    __syncthreads();
    const XcdBarrier xbar = xcd_barrier_post((unsigned*)args.ws, (volatile LAS unsigned*)(F0.lds + LDS_CTL_OFF));
#define PH_ON() (ph >= lo && ph < hi)
#define PH_CTX() const Ctx F = fresh(F0); unsigned char* ws = F.ws; (void)ws
#define PH_END() do { if (ph >= lo && ph + 1 < hi) { if (lo < 0) grid.sync(); else xcd_barrier(xbar); } ++ph; } while (0)

    if (PH_ON()) { PH_CTX(); prologue_phase(F); }
    PH_END();

#pragma unroll 1
    for (int i = 0; i < DEPTH; ++i) {
        const int j = i >> 1;
        if ((i & 1) == 0) {
            if (PH_ON()) { PH_CTX();
                { LoadBf16 la{ASM, 1024}; EpiSIn ep{SSS(2 * i), F.in[I_STSC] + (size_t)j * SB * 2 * DM, F.in[I_SCCW] + (size_t)j * 3 * DM, ZC, BGS, F.out + O_SSC + (size_t)j * SB * 2 * DM};
                  skinny_gemm(F, la, ep, (const bf16*)(ws + WS_WIN) + (size_t)j * 3072 * 1024, 3072, 1024, 64, F.G - 1 - F.bid, F.G); }
                pg8::Gemm g{HN, (const bf16*)(ws + WS_WIN) + (size_t)j * 3072 * 1024, M, 3072, 1024}; TripletOrder S; S.init(F.G, F.bid);
                preload_rtab(F, S, SSP(2 * i));
                EpiInF E{ZB, UB, F.out + O_PSC + (size_t)j * NBATCH * 2 * DM, (const LAS float*)(F.lds + LDS_RTAB_OFF), F.in[I_SCCW] + (size_t)j * 3 * DM, (float*)(ws + WS_GH), (float*)(ws + WS_PRE), (float*)(ws + WS_UH), (LAS float*)(F.lds + LDS_HALO_OFF)};
                pg8::gemm_phase<EpiInF, TripletOrder, true, PG8_SP2>(F.lds, g, S, E, F.tid);
            }
            PH_END();
        } else {
            if (PH_ON()) { PH_CTX();
                const int GQ = F.G == 256 ? 232 : ((F.G - 24) & ~7);
                { LoadBf16 la{ASM, 1024}; EpiSQKV ep{SSS(2 * i), RAWA};
                  skinny_gemm(F, la, ep, (const bf16*)(ws + WS_WQKV) + (size_t)j * QKVW * 1024, QKVW, 1024, 0, F.bid - (GQ - 8), F.G - (GQ - 8)); }
                pg8::Gemm g{HN, (const bf16*)(ws + WS_WQKV) + (size_t)j * QKVW * 1024, M, QKVW, 1024}; pg8::StaticOrder S; S.init(M, QKVW, GQ, F.bid, WGM_QKV);
                const float* qnp = F.in[I_QN] + (size_t)j * HD; const float* knp = F.in[I_KN] + (size_t)j * HD;
                EpiQKV E{QP, qnp, (long)(knp - qnp), F.out, j, (const LAS float*)(F.lds + LDS_RTAB_OFF)};
                if (F.bid < GQ) { preload_rtab(F, S, SSP(2 * i)); pg8::gemm_phase<EpiQKV, pg8::StaticOrder, true, PG8_SP2>(F.lds, g, S, E, F.tid); gemm_done(F, i); }
                copy_while(F, i, (unsigned)GQ);
            }
            PH_END();
            if (PH_ON()) { PH_CTX(); attn_phase(F, QP, KP, VP, OUTG, LSE); sample_attn_phase(F, j, RAWA, OS); }
            PH_END();
            if (PH_ON()) { PH_CTX();
                { LoadF32 la{OS, AW}; EpiSRes ep{XS_IN(2 * i), XS_OUT(2 * i), F.in[I_NFFN] + (size_t)i * DM, ASG, SSS(2 * i + 1), nullptr};
                  skinny_gemm(F, la, ep, (const bf16*)(ws + WS_WAO) + (size_t)j * 1024 * 512, 1024, 512, 0, F.bid, 32); }
                merge_phase(F, OUTG, LSE, OB, F.bid - 32, F.G - 32);
            }
            PH_END();
        }
        if (PH_ON()) { PH_CTX();
            pg8::Gemm g; g.M = M; g.N = 1024;
            if ((i & 1) == 0) { g.A = UB; g.Bt = (const bf16*)(ws + WS_WOUT) + (size_t)j * 1024 * 1024; g.K = 1024; }
            else { g.A = OB; g.Bt = (const bf16*)(ws + WS_WAO) + (size_t)j * 1024 * 512; g.K = 512; }
            pg8::StaticOrder S; S.init(M, 1024, F.G, F.bid, WGM_MIX);
            if ((i & 1) == 0) {
                pg8::Unit u0; if (S.next(0, u0)) sc_fixup_panel(F, u0.pm, (const float*)(ws + WS_GH), (const float*)(ws + WS_PRE), (const float*)(ws + WS_UH), F.in[I_SCCW] + (size_t)j * 3 * DM, UB); }
            EpiRes E{i == 0 ? F.in[I_XP] : nullptr, HN, SSP(2 * i + 1), nullptr};
            pg8::gemm_phase<EpiRes, pg8::StaticOrder, false, PG8_SP2>(F.lds, g, S, E, F.tid);
        }
        PH_END();
        if (PH_ON()) { PH_CTX();
            const int GU = F.G == 256 ? 240 : ((F.G - 16) & ~7);
            if ((i & 1) == 0) {
                const int wk = F.bid - (GU - 32);
                { LoadMulF32 la{BGS, ZC, 1024}; EpiSRes ep{XS_IN(2 * i), XS_OUT(2 * i), F.in[I_NFFN] + (size_t)i * DM, ASG, SSS(2 * i + 1), nullptr};
                  skinny_gemm(F, la, ep, (const bf16*)(ws + WS_WOUT) + (size_t)j * 1024 * 1024, 1024, 1024, 0, wk, 32); }
                if (wk >= 0) {
                    if (F.tid == 0) { if (wk < 32) { __threadfence(); __hip_atomic_fetch_add((unsigned*)ws + CW_SOUT + 64 * i, 1u, __ATOMIC_RELAXED, __HIP_MEMORY_SCOPE_AGENT); }
                        unsigned sp = 0; while (__hip_atomic_load((unsigned*)ws + CW_SOUT + 64 * i, __ATOMIC_RELAXED, __HIP_MEMORY_SCOPE_AGENT) < 32u && ++sp < (1u << 22)) __builtin_amdgcn_s_sleep(2); __threadfence(); }
                    __syncthreads(); } }
            { LoadBf16 la{ASG, 1024}; EpiSGU ep{SSS(2 * i + 1), F.in[I_STFFN] + (size_t)i * SB * 2 * DFF, F.in[I_FCW] + (size_t)i * 3 * DFF, F.in[I_FCB] + (size_t)i * DFF, ADN, F.out + O_SFFN + (size_t)i * SB * 2 * DFF};
              skinny_gemm(F, la, ep, (const bf16*)(ws + WS_WGU) + (size_t)i * 5632 * 1024, 5632, 1024, 176, F.bid - (GU - 32), F.G - (GU - 32));
              const int wk = F.bid - (GU - 32), nwk = F.G - (GU - 32);
              if (wk >= 0 && wk < 176 && F.tid == 0) { __threadfence(); __hip_atomic_fetch_add((unsigned*)ws + CW_SGU + 64 * i, (unsigned)((176 - wk + nwk - 1) / nwk), __ATOMIC_RELAXED, __HIP_MEMORY_SCOPE_AGENT); } }
            if (F.bid >= GU) {
                if (F.tid == 0) { unsigned sp = 0; while (__hip_atomic_load((unsigned*)ws + CW_SGU + 64 * i, __ATOMIC_RELAXED, __HIP_MEMORY_SCOPE_AGENT) < 176u && ++sp < (1u << 22)) __builtin_amdgcn_s_sleep(2); __threadfence(); }
                __syncthreads();
                const bool lastl = (i == DEPTH - 1); LoadBf16 la{ADN, DFF};
                EpiSRes ep{XS_IN(2 * i + 1), lastl ? nullptr : XS_OUT(2 * i + 1), F.in[I_NMIX] + (size_t)(lastl ? i : i + 1) * DM, lastl ? nullptr : ASM, SSS(lastl ? 7 : 2 * i + 2), lastl ? F.out + O_YS : nullptr};
                skinny_gemm(F, la, ep, (const bf16*)(ws + WS_WDN) + (size_t)i * 1024 * 2816, 1024, 2816, 0, F.bid - GU, F.G - GU); }
            pg8::Gemm g{HN, (const bf16*)(ws + WS_WGU) + (size_t)i * 5632 * 1024, M, 5632, 1024}; pg8::StaticOrder S; S.init(M, 5632, GU, F.bid, WGM_GU);
            EpiGUF E{ACT, F.out + O_PFFN + (size_t)i * NBATCH * 2 * DFF, (const LAS float*)(F.lds + LDS_RTAB_OFF), F.in[I_FCW] + (size_t)i * 3 * DFF, F.in[I_FCB] + (size_t)i * DFF, (float*)(ws + WS_GH), (float*)(ws + WS_PRE), (float*)(ws + WS_UH), (LAS float*)(F.lds + LDS_HALO_OFF)};
            if (F.bid < GU) { preload_rtab(F, S, SSP(2 * i + 1)); pg8::gemm_phase<EpiGUF, pg8::StaticOrder, true, PG8_SP2>(F.lds, g, S, E, F.tid); gemm_done(F, 4 + i); }
            copy_while(F, 4 + i, (unsigned)GU);
        }
        PH_END();
        if (PH_ON()) { PH_CTX();
            pg8::Gemm g{ACT, (const bf16*)(ws + WS_WDN) + (size_t)i * 1024 * 2816, M, 1024, 2816}; pg8::StaticOrder S; S.init(M, 1024, F.G, F.bid, WGM_DN);
            { pg8::Unit u0; if (S.next(0, u0)) ffn_fixup_panel(F, u0.pm, (const float*)(ws + WS_GH), (const float*)(ws + WS_PRE), (const float*)(ws + WS_UH), F.in[I_FCW] + (size_t)i * 3 * DFF, ACT); }
            const bool lastp = (i == DEPTH - 1);
            EpiRes E{nullptr, HN, SSP(lastp ? 7 : 2 * i + 2), lastp ? F.out + O_YP : nullptr};
            pg8::gemm_phase<EpiRes, pg8::StaticOrder, false, PG8_SP2>(F.lds, g, S, E, F.tid);
        }
        PH_END();
    }
    { const Ctx F = fresh(F0); copy_while(F, 0, ~0u); }
}

extern "C" void kernel_launch(void* const* d_in, const int* in_sizes, int n_in, void* d_out, int out_size, void* d_ws, size_t ws_size, hipStream_t stream) {
    static int grid = 0;
    if (grid == 0) {
        if (n_in != 22 || (size_t)out_size != O_END || ws_size < WS_END) { fprintf(stderr, "kernel_launch: unexpected problem geometry (n_in %d, out %d, ws %zu; need 22, %zu, >= %zu)\n", n_in, out_size, ws_size, (size_t)O_END, (size_t)WS_END); grid = -1; return; }
        int dev = 0, cus = 0, per_cu = 0;
        if (hipGetDevice(&dev) != hipSuccess || hipDeviceGetAttribute(&cus, hipDeviceAttributeMultiprocessorCount, dev) != hipSuccess) { fprintf(stderr, "kernel_launch: device query failed\n"); grid = -1; return; }
        if (hipFuncSetAttribute((const void*)mega_fwd, hipFuncAttributeMaxDynamicSharedMemorySize, LDS_BYTES) != hipSuccess) { fprintf(stderr, "kernel_launch: hipFuncSetAttribute failed\n"); grid = -1; return; }
        if (hipOccupancyMaxActiveBlocksPerMultiprocessor(&per_cu, (const void*)mega_fwd, NTHR, LDS_BYTES) != hipSuccess || per_cu < 1) { fprintf(stderr, "kernel_launch: occupancy query gave %d\n", per_cu); per_cu = 1; }
        (void)hipGetLastError();
        grid = cus * (per_cu > 1 ? 1 : per_cu);
    }
    if (grid < 0) return;
    if (hipMemsetAsync(d_ws, 0, 32768, stream) != hipSuccess) { fprintf(stderr, "kernel_launch: memset of the barrier words failed\n"); return; }
    Args a{};
    for (int i = 0; i < 22; ++i) a.in[i] = (const float*)d_in[i];
    a.out = (float*)d_out; a.ws = (unsigned char*)d_ws; a.ph_lo = 0; a.ph_hi = 1000;
#if defined(MK_PER_PHASE)
    for (int p = 0; p < 64; ++p) { a.ph_lo = p; a.ph_hi = p + 1; hipLaunchKernelGGL(mega_fwd, dim3(grid), dim3(NTHR), LDS_BYTES, stream, a); }
#else
    void* params[] = {&a};
    hipError_t e = hipLaunchCooperativeKernel((const void*)mega_fwd, dim3(grid), dim3(NTHR), params, LDS_BYTES, stream);
    if (e != hipSuccess) fprintf(stderr, "kernel_launch: cooperative launch failed: %s (grid %d)\n", hipGetErrorString(e), grid);
#endif
}
```
